# Optimizing an MI355X kernel written in HIP

```python
import math
import jax, jax.numpy as jnp
from jax import lax
import numpy as np

D_MODEL = 1024
BATCH = 8
SEQ = 8192
DEPTH = 2
DEC_BATCH = 32
DEC_SEQ = 64
PAST_LEN = 2048

CHUNK = 64
Q_BLOCK = 128
N_DIFF_HEADS = 4
DIFF_DV = 128
DIFF_DK = DIFF_DV // 2
DIFF_WIDTH = N_DIFF_HEADS * DIFF_DV
POOL_WINDOWS = (2, 4, 8, 16)
N_POOL_GROUPS = len(POOL_WINDOWS)
POOL_WIDTH = D_MODEL - DIFF_WIDTH
POOL_GC = POOL_WIDTH // N_POOL_GROUPS
POOL_HIST = max(POOL_WINDOWS) - 1
IN_WIDTH = 3 * DIFF_WIDTH + POOL_WIDTH
N_MEM = 256
N_X_HEADS = 4
X_HEAD_DIM = D_MODEL // N_X_HEADS
D_FF = 4 * D_MODEL
NORM_EPS = 1e-6
SUBLN_EPS = 1e-5

kernel_name = 'hybrid_diffattn_pool_stream_step'


def _rmsnorm(x, g, eps=NORM_EPS):
    xf = x.astype(jnp.float32)
    y = xf * lax.rsqrt(jnp.mean(xf * xf, axis=-1, keepdims=True) + eps)
    return (y * g.astype(jnp.float32)).astype(x.dtype)


def _split_proj(h, w_in):
    B, S, _ = h.shape
    z = h @ w_in
    q = z[..., :DIFF_WIDTH].reshape(B, S, 2, N_DIFF_HEADS, DIFF_DK)
    k = z[..., DIFF_WIDTH:2 * DIFF_WIDTH].reshape(B, S, 2, N_DIFF_HEADS, DIFF_DK)
    v = z[..., 2 * DIFF_WIDTH:3 * DIFF_WIDTH].reshape(B, S, N_DIFF_HEADS, DIFF_DV)
    u = z[..., 3 * DIFF_WIDTH:]
    return q, k, v, u


def _lambda(lam_q, lam_k, lam_init):
    lf = jnp.sum(lam_q.astype(jnp.float32) * lam_k.astype(jnp.float32), axis=-1)
    return jnp.exp(lf[0]) - jnp.exp(lf[1]) + lam_init


def _chunk_mask(q_pos, k_pos):
    return (k_pos[None, :] // CHUNK) <= (q_pos[:, None] // CHUNK)


def _diff_attention(q, k, v, q_pos, k_pos, lam):
    s = jnp.einsum('bqmhd,bkmhd->bmhqk', q, k).astype(jnp.float32) * (DIFF_DK ** -0.5)
    s = jnp.where(_chunk_mask(q_pos, k_pos), s, -jnp.inf)
    p = jax.nn.softmax(s, axis=-1)
    a = (p[:, 0] - lam * p[:, 1]).astype(v.dtype)
    return jnp.einsum('bhqk,bkhd->bqhd', a, v)


def _blocked_diff_attention(q, k, v, lam):
    B, S = q.shape[:2]
    nb = S // Q_BLOCK
    qb = jnp.moveaxis(q.reshape(B, nb, Q_BLOCK, 2, N_DIFF_HEADS, DIFF_DK), 1, 0)
    k_pos = jnp.arange(S)

    def one(args):
        q_blk, i = args
        q_pos = i * Q_BLOCK + jnp.arange(Q_BLOCK)
        return _diff_attention(q_blk, k, v, q_pos, k_pos, lam)

    o = lax.map(one, (qb, jnp.arange(nb)))
    return jnp.moveaxis(o, 0, 1).reshape(B, S, N_DIFF_HEADS, DIFF_DV)


def _diff_post(o, subln_g, lam_init):
    B, S = o.shape[:2]
    return (_rmsnorm(o, subln_g, SUBLN_EPS) * (1.0 - lam_init)).reshape(B, S, DIFF_WIDTH)


def _pool_branch(u, hist, start, w_pool, pool_scale):
    B, S, P = u.shape
    ext = jnp.concatenate([hist, u], axis=1)
    cs = jnp.cumsum(ext.astype(jnp.float32), axis=1)
    cs = jnp.pad(cs, ((0, 0), (1, 0), (0, 0)))
    pos = start + jnp.arange(S)
    means = []
    for g, w in enumerate(POOL_WINDOWS):
        sl = slice(g * POOL_GC, (g + 1) * POOL_GC)
        win = cs[:, POOL_HIST + 1:POOL_HIST + 1 + S, sl] - cs[:, POOL_HIST + 1 - w:POOL_HIST + 1 - w + S, sl]
        cnt = jnp.minimum(w, pos + 1).astype(jnp.float32)[None, :, None]
        means.append(win / cnt)
    mean = jnp.stack(means, axis=2)
    pooled = (mean - u.astype(jnp.float32).reshape(B, S, N_POOL_GROUPS, POOL_GC)).astype(u.dtype)
    y = jnp.einsum('bsgc,gcd->bsgd', pooled, w_pool).reshape(B, S, P) * pool_scale
    return y, ext[:, -POOL_HIST:]


def _mem_kv(mem, g, wk, wv):
    B = mem.shape[0]
    m = _rmsnorm(mem, g)
    mk = (m @ wk).reshape(B, N_MEM, N_X_HEADS, X_HEAD_DIM)
    mv = (m @ wv).reshape(B, N_MEM, N_X_HEADS, X_HEAD_DIM)
    return mk, mv


def _cross_attn(h, mk, mv, wq, wo):
    B, S, _ = h.shape
    q = (h @ wq).reshape(B, S, N_X_HEADS, X_HEAD_DIM)
    s = jnp.einsum('bshd,bmhd->bhsm', q, mk).astype(jnp.float32) * (X_HEAD_DIM ** -0.5)
    p = jax.nn.softmax(s, axis=-1).astype(mv.dtype)
    o = jnp.einsum('bhsm,bmhd->bshd', p, mv).reshape(B, S, D_MODEL)
    return o @ wo


def _mlp(h, w_up, w_down):
    return jnp.square(jax.nn.relu(h @ w_up)) @ w_down


def _rest(x, a, pool_y, w_out, mk, mv, norm_x_g, wq_x, wo_x, norm_mlp_g, w_up, w_down):
    x = x + jnp.concatenate([a, pool_y], axis=-1) @ w_out
    x = x + _cross_attn(_rmsnorm(x, norm_x_g), mk, mv, wq_x, wo_x)
    return x + _mlp(_rmsnorm(x, norm_mlp_g), w_up, w_down)


def setup_inputs(seed: int = 0) -> dict:
    key = jax.random.key(seed)
    ks = iter(jax.random.split(key, 32))
    f32 = jnp.float32

    def nrm(shape, scale=1.0):
        return jax.random.normal(next(ks), shape, f32) * scale

    def gain(shape):
        return 1.0 + 0.05 * jax.random.normal(next(ks), shape, f32)

    return {
        'x_prompt': nrm((BATCH, SEQ, D_MODEL)),
        'x_sample': nrm((DEC_BATCH, DEC_SEQ, D_MODEL)),
        'cache_k': nrm((DEPTH, DEC_BATCH, PAST_LEN, 2, N_DIFF_HEADS, DIFF_DK)),
        'cache_v': nrm((DEPTH, DEC_BATCH, PAST_LEN, N_DIFF_HEADS, DIFF_DV)),
        'state_pool': nrm((DEPTH, DEC_BATCH, POOL_HIST, POOL_WIDTH)),
        'cache_mem_k': nrm((DEPTH, DEC_BATCH, N_MEM, N_X_HEADS, X_HEAD_DIM)),
        'cache_mem_v': nrm((DEPTH, DEC_BATCH, N_MEM, N_X_HEADS, X_HEAD_DIM)),
        'mem_prompt': nrm((BATCH, N_MEM, D_MODEL)),
        'norm_mix_g': gain((DEPTH, D_MODEL)),
        'w_in': nrm((DEPTH, D_MODEL, IN_WIDTH), D_MODEL ** -0.5),
        'lam_q': nrm((DEPTH, 2, DIFF_DK), 0.1),
        'lam_k': nrm((DEPTH, 2, DIFF_DK), 0.1),
        'subln_g': gain((DEPTH, DIFF_DV)),
        'w_pool': nrm((DEPTH, N_POOL_GROUPS, POOL_GC, POOL_GC), POOL_GC ** -0.5),
        'pool_scale': gain((DEPTH, POOL_WIDTH)),
        'w_out': nrm((DEPTH, D_MODEL, D_MODEL), D_MODEL ** -0.5),
        'norm_x_g': gain((DEPTH, D_MODEL)),
        'norm_mem_g': gain((DEPTH, D_MODEL)),
        'wq_x': nrm((DEPTH, D_MODEL, D_MODEL), D_MODEL ** -0.5),
        'wk_x': nrm((DEPTH, D_MODEL, D_MODEL), D_MODEL ** -0.5),
        'wv_x': nrm((DEPTH, D_MODEL, D_MODEL), D_MODEL ** -0.5),
        'wo_x': nrm((DEPTH, D_MODEL, D_MODEL), D_MODEL ** -0.5),
        'norm_mlp_g': gain((DEPTH, D_MODEL)),
        'w_up': nrm((DEPTH, D_MODEL, D_FF), D_MODEL ** -0.5),
        'w_down': nrm((DEPTH, D_FF, D_MODEL), D_FF ** -0.5),
        'final_g': gain((D_MODEL,)),
    }


def reference(x_prompt, x_sample, cache_k, cache_v, state_pool, cache_mem_k, cache_mem_v, mem_prompt,
              norm_mix_g, w_in, lam_q, lam_k, subln_g, w_pool, pool_scale, w_out,
              norm_x_g, norm_mem_g, wq_x, wk_x, wv_x, wo_x, norm_mlp_g, w_up, w_down, final_g):
    xp, xs = x_prompt, x_sample
    past = cache_k.shape[2]
    n_new = xs.shape[1]
    q_pos_s = past + jnp.arange(n_new)
    k_pos_s = jnp.arange(past + n_new)
    zero_hist = jnp.zeros((xp.shape[0], POOL_HIST, POOL_WIDTH), xp.dtype)
    kp_l, vp_l, pp_l, mkp_l, mvp_l, ks_l, vs_l, ps_l = [], [], [], [], [], [], [], []
    for l in range(DEPTH):
        lam_init = 0.8 - 0.6 * math.exp(-0.3 * l)
        lam = _lambda(lam_q[l], lam_k[l], lam_init)

        q, k, v, u = _split_proj(_rmsnorm(xp, norm_mix_g[l]), w_in[l])
        a = _diff_post(_blocked_diff_attention(q, k, v, lam), subln_g[l], lam_init)
        pool_y, hist_p = _pool_branch(u, zero_hist, 0, w_pool[l], pool_scale[l])
        mk, mv = _mem_kv(mem_prompt, norm_mem_g[l], wk_x[l], wv_x[l])
        xp = _rest(xp, a, pool_y, w_out[l], mk, mv, norm_x_g[l], wq_x[l], wo_x[l],
                   norm_mlp_g[l], w_up[l], w_down[l])
        kp_l.append(k); vp_l.append(v); pp_l.append(hist_p); mkp_l.append(mk); mvp_l.append(mv)

        q, k, v, u = _split_proj(_rmsnorm(xs, norm_mix_g[l]), w_in[l])
        k_all = jnp.concatenate([cache_k[l], k], axis=1)
        v_all = jnp.concatenate([cache_v[l], v], axis=1)
        a = _diff_post(_diff_attention(q, k_all, v_all, q_pos_s, k_pos_s, lam), subln_g[l], lam_init)
        pool_y, hist_s = _pool_branch(u, state_pool[l], past, w_pool[l], pool_scale[l])
        xs = _rest(xs, a, pool_y, w_out[l], cache_mem_k[l], cache_mem_v[l], norm_x_g[l], wq_x[l], wo_x[l],
                   norm_mlp_g[l], w_up[l], w_down[l])
        ks_l.append(k); vs_l.append(v); ps_l.append(hist_s)

    y_prompt = _rmsnorm(xp, final_g)
    y_sample = _rmsnorm(xs, final_g)
    return (y_prompt, y_sample,
            jnp.stack(kp_l), jnp.stack(vp_l), jnp.stack(pp_l), jnp.stack(mkp_l), jnp.stack(mvp_l),
            jnp.stack(ks_l), jnp.stack(vs_l), jnp.stack(ps_l))
```

```cpp
#include <hip/hip_runtime.h>
#include <hip/hip_bf16.h>
#include <cstdio>
#include <cstdint>
constexpr int ZLD = 4096;

#ifndef USE_SHFL
#define USE_SHFL 0
#endif
#if USE_SHFL
template <int K> __device__ __forceinline__ float swz_xor(float v) { return __shfl_xor(v, K); }
#else
template <int K> __device__ __forceinline__ float swz_xor(float v) { return __builtin_bit_cast(float, __builtin_amdgcn_ds_swizzle(__builtin_bit_cast(int, v), (K << 10) | 0x1f)); }
#endif
__device__ __forceinline__ float xsum32(float v) { v += swz_xor<1>(v); v += swz_xor<2>(v); v += swz_xor<4>(v); v += swz_xor<8>(v); v += swz_xor<16>(v); return v; }
__device__ __forceinline__ float xsum64(float v) { v = xsum32(v); return __builtin_bit_cast(float, __builtin_amdgcn_readlane(__builtin_bit_cast(int, v), 0)) + __builtin_bit_cast(float, __builtin_amdgcn_readlane(__builtin_bit_cast(int, v), 32)); }
namespace pg8 {
#define PG8_LAS __attribute__((address_space(3)))
typedef unsigned short bf16_t;
typedef short bf16x8 __attribute__((ext_vector_type(8)));
typedef float f32x4 __attribute__((ext_vector_type(4)));
typedef unsigned u32x4 __attribute__((ext_vector_type(4)));
constexpr int BM = 256, BK = 64, HALF = 128, HTB = HALF * BK * 2  , STAGE_BYTES = 8 * HTB, NXCD = 8, WGM = 8;

__host__ __device__ __forceinline__ int lds_byte(int r, int c) { const int st = (r >> 4) * 2 + (c >> 5), rr = r & 15, cc = c & 31, ob = rr * 64 + cc * 2; return st * 1024 + (ob ^ (((ob >> 9) & 1) << 5)); }
__host__ __device__ __forceinline__ void stage_rc(int b, int& R, int& C) { const int st = b / 1024, sb = b % 1024, swz = sb ^ (((sb >> 9) & 1) << 5); R = (st >> 1) * 16 + swz / 64; C = (st & 1) * 32 + (swz % 64) / 2; }
__host__ __device__ __forceinline__ int perm32(int rho) { const int n = rho >> 4, i = rho & 15; return 8 * (i >> 2) + 4 * n + (i & 3); }

struct Unit { int pm, pn; };
struct Gemm { const bf16_t* A; const bf16_t* Bt; int M, N, K, lda; };

struct StaticOrder {
    int nM, nN, nwg, G, c;
    __host__ __device__ void init(int M, int N, int G_, int c_) { nM = M / BM; nN = N / BM; nwg = nM * nN; G = G_; c = c_; }
    __host__ __device__ bool next(int i, Unit& u) const {
        const long L = (long)i * G + c; if (L >= nwg) return false;
        int wgid = (int)L; { const int q = nwg / NXCD, r = nwg % NXCD, xcd = wgid % NXCD, off = wgid / NXCD; wgid = (xcd < r ? xcd * (q + 1) : r * (q + 1) + (xcd - r) * q) + off; }
        const int nig = WGM * nN, gid = wgid / nig, fm = gid * WGM, gsz = (nM - fm) < WGM ? (nM - fm) : WGM;
        u.pm = fm + ((wgid % nig) % gsz); u.pn = (wgid % nig) / gsz; return true;
    }
    __device__ __forceinline__ void a_ready(const Unit&) const {}
    __device__ __forceinline__ void done(const Unit&) const {}
};

struct XcdOrder {
    int nN, x, j;
    __host__ __device__ void init(int N, int x_, int j_) { nN = N / BM; x = x_; j = j_; }
    __host__ __device__ bool next(int i, Unit& u) const {
        const int wl = i * 32 + j; if (wl >= 32 * nN) return false;
        const int nig = WGM * nN, gid = wl / nig, r = wl % nig;
        u.pm = 32 * x + gid * WGM + (r % WGM); u.pn = r / WGM; return true;
    }
    __device__ __forceinline__ void a_ready(const Unit&) const {}
    __device__ __forceinline__ void done(const Unit&) const {}
};

struct OneUnit {
    int pm, pn; bool on;
    __host__ __device__ bool next(int i, Unit& u) const { if (i != 0 || !on) return false; u.pm = pm; u.pn = pn; return true; }
    __device__ __forceinline__ void a_ready(const Unit&) const {}
    __device__ __forceinline__ void done(const Unit&) const {}
};

__device__ __forceinline__ unsigned cvt_pk_bf16(float lo, float hi) { unsigned r; asm volatile("v_cvt_pk_bf16_f32 %0, %1, %2" : "=v"(r) : "v"(lo), "v"(hi)); return r; }
typedef float f32x2 __attribute__((ext_vector_type(2)));
constexpr int NROWS_P = 65536;
constexpr float NORM_EPS_F = 1e-6f;
__device__ __forceinline__ float row_rstd(const float* ss, int row) { return 1.0f / sqrtf(ss[row] * (1.0f / 1024.0f) + NORM_EPS_F); }
__device__ __forceinline__ u32x4 pack8(f32x4 v0, f32x4 v1) { u32x4 w; w.x = cvt_pk_bf16(v0[0], v0[1]); w.y = cvt_pk_bf16(v0[2], v0[3]); w.z = cvt_pk_bf16(v1[0], v1[1]); w.w = cvt_pk_bf16(v1[2], v1[3]); return w; }

struct EpiInProj {
    static constexpr bool PERM = true, AFTER_DRAIN = false;
    const float* ss; bf16_t *Qa, *Ka, *Va, *U; float *kout_p, *vout_p, *kout_s, *vout_s, *pool_p, *pool_s; float qscale;
    __device__ __forceinline__ void operator()(const f32x4 (&acc)[2][2][4][2], const Unit& u, int wr, int wc, int fr_, int fq_) const {
        int fr = fr_, fq = fq_; asm volatile("" : "+v"(fr), "+v"(fq));
        const int sect = u.pn >> 1, half = u.pn & 1; const bool samp = u.pm >= (NROWS_P / BM);
#pragma unroll
        for (int ai = 0; ai < 2; ++ai)
#pragma unroll
            for (int m = 0; m < 4; ++m) {
                const int row = u.pm * BM + ai * HALF + wr * 64 + m * 16 + fr;
                float rs = row_rstd(ss, row); if (sect == 0) rs *= qscale;
                const int srow = row - NROWS_P;
#pragma unroll
                for (int bj = 0; bj < 2; ++bj) {
                    const int c = bj * HALF + wc * 32 + 8 * fq;
                    const f32x4 v0 = acc[ai][bj][m][0] * rs, v1 = acc[ai][bj][m][1] * rs;
                    const u32x4 w = pack8(v0, v1);
                    if (sect == 0) { *(u32x4*)(Qa + (size_t)row * ZLD + (c >> 6) * 128 + half * 64 + (c & 63)) = w; }
                    else if (sect == 1) { *(u32x4*)(Ka + (size_t)row * ZLD + (c >> 6) * 128 + half * 64 + (c & 63)) = w;
                        float* o = (samp ? kout_s + (size_t)srow * 512 : kout_p + (size_t)row * 512) + half * 256 + c; *(f32x4*)o = v0; *(f32x4*)(o + 4) = v1; }
                    else if (sect == 2) { *(u32x4*)(Va + (size_t)row * ZLD + half * 256 + c) = w;
                        float* o = (samp ? vout_s + (size_t)srow * 512 : vout_p + (size_t)row * 512) + half * 256 + c; *(f32x4*)o = v0; *(f32x4*)(o + 4) = v1; }
                    else { *(u32x4*)(U + (size_t)row * ZLD + half * 256 + c) = w;
                        if (!samp) { const int t = row & 8191, b = row >> 13; if (t >= 8192 - 15) { float* o = pool_p + ((size_t)(b * 15 + t - (8192 - 15))) * 512 + half * 256 + c; *(f32x4*)o = v0; *(f32x4*)(o + 4) = v1; } }
                        else { const int t = srow & 63, b = srow >> 6; if (t >= 64 - 15) { float* o = pool_s + ((size_t)(b * 15 + t - (64 - 15))) * 512 + half * 256 + c; *(f32x4*)o = v0; *(f32x4*)(o + 4) = v1; } } }
                }
            }
    }
};
__device__ __forceinline__ void inproj_small(const EpiInProj& E, int row, int col, f32x4 v) {
    typedef unsigned u32x2_t __attribute__((ext_vector_type(2)));
    const int sect = col >> 9, half = (col >> 8) & 1, c = col & 255, srow = row - NROWS_P;
    float rs = row_rstd(E.ss, row); if (sect == 0) rs *= E.qscale;
    v = v * rs;
    u32x2_t w; w.x = cvt_pk_bf16(v[0], v[1]); w.y = cvt_pk_bf16(v[2], v[3]);
    if (sect == 0) { *(u32x2_t*)(E.Qa + (size_t)row * ZLD + (c >> 6) * 128 + half * 64 + (c & 63)) = w; }
    else if (sect == 1) { *(u32x2_t*)(E.Ka + (size_t)row * ZLD + (c >> 6) * 128 + half * 64 + (c & 63)) = w; *(f32x4*)(E.kout_s + (size_t)srow * 512 + half * 256 + c) = v; }
    else if (sect == 2) { *(u32x2_t*)(E.Va + (size_t)row * ZLD + half * 256 + c) = w; *(f32x4*)(E.vout_s + (size_t)srow * 512 + half * 256 + c) = v; }
    else { *(u32x2_t*)(E.U + (size_t)row * ZLD + half * 256 + c) = w;
        const int t = srow & 63, b = srow >> 6; if (t >= 64 - 15) *(f32x4*)(E.pool_s + ((size_t)(b * 15 + t - (64 - 15))) * 512 + half * 256 + c) = v; }
}
__device__ __forceinline__ float bf_lo(unsigned w) { return __builtin_bit_cast(float, w << 16); }
__device__ __forceinline__ float bf_hi(unsigned w) { return __builtin_bit_cast(float, w & 0xffff0000u); }
struct EpiRes {
    static constexpr bool PERM = true, AFTER_DRAIN = false;
    bf16_t* xb; float* ss_next;
    __device__ __forceinline__ void operator()(const f32x4 (&acc)[2][2][4][2], const Unit& u, int wr, int wc, int fr_, int fq_) const {
        int fr = fr_, fq = fq_; asm volatile("" : "+v"(fr), "+v"(fq));
#pragma unroll
        for (int ai = 0; ai < 2; ++ai) {
            float tot = 0.f;
#pragma unroll
            for (int m = 0; m < 4; ++m) {
                const int row = u.pm * BM + ai * HALF + wr * 64 + m * 16 + fr; float s = 0.f;
#pragma unroll
                for (int bj = 0; bj < 2; ++bj) {
                    const size_t off = (size_t)row * 1024 + u.pn * BM + bj * HALF + wc * 32 + 8 * fq;
                    const u32x4 xo = *(const u32x4*)(xb + off);
                    f32x4 x0 = {bf_lo(xo.x), bf_hi(xo.x), bf_lo(xo.y), bf_hi(xo.y)}, x1 = {bf_lo(xo.z), bf_hi(xo.z), bf_lo(xo.w), bf_hi(xo.w)};
                    x0 += acc[ai][bj][m][0]; x1 += acc[ai][bj][m][1];
                    const u32x4 xn = pack8(x0, x1);
                    *(u32x4*)(xb + off) = xn;
                    const float r0 = bf_lo(xn.x), r1 = bf_hi(xn.x), r2 = bf_lo(xn.y), r3 = bf_hi(xn.y), r4 = bf_lo(xn.z), r5 = bf_hi(xn.z), r6 = bf_lo(xn.w), r7 = bf_hi(xn.w);
                    s += (r0 * r0 + r1 * r1) + (r2 * r2 + r3 * r3) + (r4 * r4 + r5 * r5) + (r6 * r6 + r7 * r7);
                }
                s += swz_xor<16>(s);
                float sa = s, sb = s;
                asm volatile("s_nop 1\n\tv_permlane32_swap_b32 %0, %1\n\ts_nop 1" : "+v"(sa), "+v"(sb));
                const float t = sa + sb;
                tot = (fq == m) ? t : tot;
            }
            atomicAdd(ss_next + (u.pm * BM + ai * HALF + wr * 64) + fq * 16 + fr, tot);
        }
    }
};
template <int ACT> struct EpiRowScale {
    static constexpr bool PERM = true, AFTER_DRAIN = false;
    const float* ss; bf16_t* O; int ldc; float scale;
    __device__ __forceinline__ void operator()(const f32x4 (&acc)[2][2][4][2], const Unit& u, int wr, int wc, int fr_, int fq_) const {
        int fr = fr_, fq = fq_; asm volatile("" : "+v"(fr), "+v"(fq));
#pragma unroll
        for (int ai = 0; ai < 2; ++ai)
#pragma unroll
            for (int m = 0; m < 4; ++m) {
                const int row = u.pm * BM + ai * HALF + wr * 64 + m * 16 + fr; const float rs = row_rstd(ss, row) * scale;
#pragma unroll
                for (int bj = 0; bj < 2; ++bj) {
                    f32x4 v0 = acc[ai][bj][m][0] * rs, v1 = acc[ai][bj][m][1] * rs;
                    if (ACT == 1) {
#pragma unroll
                        for (int e = 0; e < 4; ++e) { const float a = fmaxf(v0[e], 0.f), b = fmaxf(v1[e], 0.f); v0[e] = a * a; v1[e] = b * b; } }
                    __builtin_nontemporal_store(pack8(v0, v1), (u32x4*)(O + (size_t)row * ldc + u.pn * BM + bj * HALF + wc * 32 + 8 * fq));
                }
            }
    }
};
struct EpiMemKV {
    static constexpr bool PERM = true, AFTER_DRAIN = false;
    const float* ss; float *kout, *vout; bf16_t *kb, *vb;
    __device__ __forceinline__ void operator()(const f32x4 (&acc)[2][2][4][2], const Unit& u, int wr, int wc, int fr_, int fq_) const {
        int fr = fr_, fq = fq_; asm volatile("" : "+v"(fr), "+v"(fq));
        const int sel = u.pn >> 2, layer = sel >> 1; const bool isv = sel & 1;
        float* of = (isv ? vout : kout) + (size_t)layer * 2048 * 1024; bf16_t* ob = (isv ? vb : kb) + (size_t)layer * 2048 * 1024;
#pragma unroll
        for (int ai = 0; ai < 2; ++ai)
#pragma unroll
            for (int m = 0; m < 4; ++m) {
                const int row = u.pm * BM + ai * HALF + wr * 64 + m * 16 + fr; const float rs = row_rstd(ss, row);
#pragma unroll
                for (int bj = 0; bj < 2; ++bj) {
                    const size_t off = (size_t)row * 1024 + (u.pn & 3) * BM + bj * HALF + wc * 32 + 8 * fq;
                    const f32x4 v0 = acc[ai][bj][m][0] * rs, v1 = acc[ai][bj][m][1] * rs;
                    *(f32x4*)(of + off) = v0; *(f32x4*)(of + off + 4) = v1; *(u32x4*)(ob + off) = pack8(v0, v1);
                }
            }
    }
};
template <class Epi, class Sched, bool ALIGN_EPI = false, bool SP2 = false>
__device__ __forceinline__ void gemm_phase(PG8_LAS unsigned char* lds, const Gemm g, const Sched& S, const Epi& E) {
    int tid_ = threadIdx.x; asm volatile("" : "+v"(tid_));
    const int tid = tid_, wid = __builtin_amdgcn_readfirstlane(tid >> 6), lane = tid & 63, wr = wid >> 2, wc = wid & 3, fr = lane & 15, fq = lane >> 4;
    const int K = g.K, nt = K / BK;
    unsigned voffA[2], voffB[2];
#pragma unroll
    for (int i = 0; i < 2; ++i) { int R, C; stage_rc(tid * 16 + i * 8192, R, C); const int Rb = Epi::PERM ? ((R & ~31) + perm32(R & 31)) : R;
        voffA[i] = (unsigned)(R * g.lda + C) * 2u; voffB[i] = (unsigned)(Rb * K + C) * 2u; }
    const size_t kstep = (size_t)(BK * 2);
    const size_t hstepB = (size_t)HALF * K * 2, hstepA = (size_t)HALF * g.lda * 2;
    const size_t tstepB = 2 * hstepB, tstepA = 2 * hstepA;
    const unsigned ldsw = (unsigned)wid * 1024u;
    const int aoff = lds_byte(wr * 64 + fr, fq * 8), boff = lds_byte(wc * 32 + fr, fq * 8);
#define PG8_SA(b, h) (((b) * 2 + (h)) * HTB)
#define PG8_SB(b, h) ((4 + (b) * 2 + (h)) * HTB)
#define PG8_STAGE(bufoff, gbase, voff) do { _Pragma("unroll") for (int _i = 0; _i < 2; ++_i) \
        __builtin_amdgcn_global_load_lds((const unsigned*)((const char*)(gbase) + (voff)[_i]), (PG8_LAS unsigned*)(lds + (bufoff) + ldsw + _i * 8192), 16, 0, 0); } while (0)
#define PG8_LDA(dst, b, h) do { _Pragma("unroll") for (int m = 0; m < 4; ++m) _Pragma("unroll") for (int k = 0; k < 2; ++k) dst[m][k] = *(const PG8_LAS bf16x8*)(lds + PG8_SA(b, h) + aoff + m * 2048 + k * 1024); } while (0)
#define PG8_LDB(dst, b, h) do { _Pragma("unroll") for (int n = 0; n < 2; ++n) _Pragma("unroll") for (int k = 0; k < 2; ++k) dst[n][k] = *(const PG8_LAS bf16x8*)(lds + PG8_SB(b, h) + boff + n * 2048 + k * 1024); } while (0)
#define PG8_MMA(ai, bj, At, Bt) do { __builtin_amdgcn_s_setprio(1); _Pragma("unroll") for (int m = 0; m < 4; ++m) _Pragma("unroll") for (int n = 0; n < 2; ++n) _Pragma("unroll") for (int k = 0; k < 2; ++k) \
        acc[ai][bj][m][n] = __builtin_amdgcn_mfma_f32_16x16x32_bf16(Bt[n][k], At[m][k], acc[ai][bj][m][n], 0, 0, 0); __builtin_amdgcn_s_setprio(0); } while (0)
#define PG8_WAIT_V(n) asm volatile("s_waitcnt vmcnt(" #n ")" ::: "memory")
#define PG8_WAIT_L(n) asm volatile("s_waitcnt lgkmcnt(" #n ")" ::: "memory")
#define PG8_BAR __builtin_amdgcn_s_barrier()
#define PG8_SCHED __builtin_amdgcn_sched_barrier(0)
    Unit cur, nxt; int ui = 0;
    if (!S.next(0, cur)) return;
    f32x4 acc[2][2][4][2];
#pragma unroll
    for (int a = 0; a < 2; ++a)
#pragma unroll
        for (int b = 0; b < 2; ++b)
#pragma unroll
            for (int m = 0; m < 4; ++m)
#pragma unroll
                for (int n = 0; n < 2; ++n) acc[a][b][m][n] = (f32x4){0.f, 0.f, 0.f, 0.f};
    bf16x8 At[4][2], B0[2][2], B1[2][2];
    const char* cA = (const char*)g.A + (size_t)cur.pm * tstepA; const char* cB = (const char*)g.Bt + (size_t)cur.pn * tstepB;
    S.a_ready(cur);
    if constexpr (SP2) {
        PG8_STAGE(PG8_SB(0, 0), cB, voffB); PG8_STAGE(PG8_SB(0, 1), cB + hstepB, voffB); PG8_STAGE(PG8_SA(0, 0), cA, voffA); PG8_STAGE(PG8_SA(0, 1), cA + hstepA, voffA);
        if (wr == 1) PG8_BAR;
        PG8_WAIT_V(2); PG8_BAR;
        PG8_STAGE(PG8_SB(1, 0), cB + kstep, voffB); PG8_STAGE(PG8_SA(1, 0), cA + kstep, voffA); PG8_STAGE(PG8_SB(1, 1), cB + hstepB + kstep, voffB);
        PG8_WAIT_V(6); PG8_BAR;
    } else {
        PG8_STAGE(PG8_SB(0, 0), cB, voffB); PG8_STAGE(PG8_SA(0, 0), cA, voffA); PG8_STAGE(PG8_SB(0, 1), cB + hstepB, voffB); PG8_STAGE(PG8_SA(0, 1), cA + hstepA, voffA);
        if (wr == 1) PG8_BAR;
        PG8_WAIT_V(4); PG8_BAR;
        PG8_STAGE(PG8_SB(1, 0), cB + kstep, voffB); PG8_STAGE(PG8_SA(1, 0), cA + kstep, voffA); PG8_STAGE(PG8_SB(1, 1), cB + hstepB + kstep, voffB);
        PG8_WAIT_V(6); PG8_BAR;
    }
    for (;;) {
        const bool has_next = S.next(ui + 1, nxt);
        const char* nA = has_next ? (const char*)g.A + (size_t)nxt.pm * tstepA : cA; const char* nB = has_next ? (const char*)g.Bt + (size_t)nxt.pn * tstepB : cB;
        for (int t = 0; t < nt; t += 2) {
            const bool last = (t == nt - 2);
            const char* a1 = cA + (size_t)(t + 1) * kstep;
            const char* a2 = last ? nA : cA + (size_t)(t + 2) * kstep; const char* b2 = last ? nB : cB + (size_t)(t + 2) * kstep;
            const char* a3 = a2 + kstep; const char* b3 = b2 + kstep;
            if (last && has_next) S.a_ready(nxt);
            if constexpr (SP2) {
            PG8_LDB(B0, 0, 0); PG8_LDB(B1, 0, 1); PG8_SCHED; PG8_LDA(At, 0, 0); PG8_STAGE(PG8_SA(1, 1), a1 + hstepA, voffA);
            PG8_WAIT_V(8); PG8_WAIT_L(0); PG8_BAR; PG8_MMA(0, 0, At, B0); PG8_MMA(0, 1, At, B1); PG8_BAR; PG8_SCHED;
            PG8_LDA(At, 0, 1); PG8_STAGE(PG8_SB(0, 0), b2, voffB); PG8_STAGE(PG8_SB(0, 1), b2 + hstepB, voffB); PG8_STAGE(PG8_SA(0, 0), a2, voffA);
            PG8_WAIT_V(8); PG8_WAIT_L(0); PG8_BAR; PG8_MMA(1, 0, At, B0); PG8_MMA(1, 1, At, B1); PG8_BAR; PG8_SCHED;
            PG8_LDB(B0, 1, 0); PG8_LDB(B1, 1, 1); PG8_SCHED; PG8_LDA(At, 1, 0); PG8_STAGE(PG8_SA(0, 1), a2 + hstepA, voffA);
            PG8_WAIT_V(8); PG8_WAIT_L(0); PG8_BAR; PG8_MMA(0, 0, At, B0); PG8_MMA(0, 1, At, B1); PG8_BAR; PG8_SCHED;
            PG8_LDA(At, 1, 1); PG8_STAGE(PG8_SB(1, 0), b3, voffB); PG8_STAGE(PG8_SB(1, 1), b3 + hstepB, voffB); PG8_STAGE(PG8_SA(1, 0), a3, voffA);
            PG8_WAIT_V(8); PG8_WAIT_L(0); PG8_BAR; PG8_MMA(1, 0, At, B0); PG8_MMA(1, 1, At, B1); PG8_BAR; PG8_SCHED;
            } else {
            PG8_LDB(B0, 0, 0); PG8_SCHED; PG8_LDA(At, 0, 0); PG8_STAGE(PG8_SA(1, 1), a1 + hstepA, voffA);
            PG8_WAIT_L(8); PG8_BAR; PG8_WAIT_L(0); PG8_MMA(0, 0, At, B0); PG8_BAR; PG8_SCHED;
            PG8_LDB(B1, 0, 1); PG8_STAGE(PG8_SB(0, 0), b2, voffB);
            PG8_BAR; PG8_WAIT_L(0); PG8_MMA(0, 1, At, B1); PG8_BAR;
            PG8_LDA(At, 0, 1); PG8_STAGE(PG8_SA(0, 0), a2, voffA);
            PG8_BAR; PG8_WAIT_L(0); PG8_MMA(1, 0, At, B0); PG8_BAR; PG8_SCHED;
            PG8_STAGE(PG8_SB(0, 1), b2 + hstepB, voffB);
            PG8_WAIT_V(6); PG8_BAR; PG8_MMA(1, 1, At, B1); PG8_BAR;
            PG8_LDB(B0, 1, 0); PG8_SCHED; PG8_LDA(At, 1, 0); PG8_STAGE(PG8_SA(0, 1), a2 + hstepA, voffA);
            PG8_WAIT_L(8); PG8_BAR; PG8_WAIT_L(0); PG8_MMA(0, 0, At, B0); PG8_BAR; PG8_SCHED;
            PG8_LDB(B1, 1, 1); PG8_STAGE(PG8_SB(1, 0), b3, voffB);
            PG8_BAR; PG8_WAIT_L(0); PG8_MMA(0, 1, At, B1); PG8_BAR;
            PG8_LDA(At, 1, 1); PG8_STAGE(PG8_SA(1, 0), a3, voffA);
            PG8_BAR; PG8_WAIT_L(0); PG8_MMA(1, 0, At, B0); PG8_BAR; PG8_SCHED;
            PG8_STAGE(PG8_SB(1, 1), b3 + hstepB, voffB);
            PG8_WAIT_V(6); PG8_BAR; PG8_MMA(1, 1, At, B1); PG8_BAR;
            }
        }
        if constexpr (ALIGN_EPI) { if (wr == 0) PG8_BAR; }
        if constexpr (!Epi::AFTER_DRAIN) { E(acc, cur, wr, wc, fr, fq); S.done(cur); }
        if (!has_next) break;
#pragma unroll
        for (int a = 0; a < 2; ++a)
#pragma unroll
            for (int b = 0; b < 2; ++b)
#pragma unroll
                for (int m = 0; m < 4; ++m)
#pragma unroll
                    for (int n = 0; n < 2; ++n) acc[a][b][m][n] = (f32x4){0.f, 0.f, 0.f, 0.f};
        cur = nxt; cA = nA; cB = nB; ++ui;
        if constexpr (ALIGN_EPI) { if (wr == 1) PG8_BAR; }
    }
    PG8_WAIT_V(0);
    if constexpr (!ALIGN_EPI) { if (wr == 0) PG8_BAR; }
    PG8_BAR;
    if constexpr (Epi::AFTER_DRAIN) { E.fused(acc, cur, wr, wc, fr, fq, lds, wid, lane); S.done(cur); }
#undef PG8_SA
#undef PG8_SB
#undef PG8_STAGE
#undef PG8_LDA
#undef PG8_LDB
#undef PG8_MMA
#undef PG8_WAIT_V
#undef PG8_WAIT_L
#undef PG8_BAR
#undef PG8_SCHED
}

template <int CB, int KIND, int ACT, int KC  , class Epi>
__device__ __forceinline__ void small_gemm(PG8_LAS unsigned char* lds, const bf16_t* A  , int lda, const bf16_t* Bt, int K, int row_base  , int t  , const Epi& E) {
    int tid_ = threadIdx.x; asm volatile("" : "+v"(tid_));
    const int lane = tid_ & 63, wid = __builtin_amdgcn_readfirstlane(tid_ >> 6), li = lane & 15, kg = lane >> 4;
    const int rb = t >> 4, cb = t & 15;
    const int col0 = cb * (16 * CB);
    constexpr int RS = 2 * KC + 16, ROWS = 128 + 16 * CB, BUF = ROWS * RS; constexpr int CPR = KC / 8  , RPP = 512 / CPR  ;
    constexpr int NA = 128 / RPP, NB = (16 * CB) / RPP;
    const int srow = tid_ / CPR, sch = tid_ % CPR;
    const bf16_t* ag = A + (size_t)(rb * 128 + srow) * lda + sch * 8;
    const bf16_t* bg = Bt + (size_t)(col0 + srow) * K + sch * 8;
    const unsigned sdst = (unsigned)(srow * RS + sch * 16);
#define SG_BAR() do { asm volatile("s_waitcnt lgkmcnt(0)" ::: "memory"); __builtin_amdgcn_s_barrier(); asm volatile("" ::: "memory"); } while (0)
    bf16x8 ra0[NA], rb0[NB], ra1[NA], rb1[NB];
#define SG_LOAD(ra, rbb, k0) do { _Pragma("unroll") for (int i = 0; i < NA; ++i) ra[i] = *(const bf16x8*)(ag + (size_t)(RPP * i) * lda + (k0)); \
        _Pragma("unroll") for (int i = 0; i < NB; ++i) rbb[i] = *(const bf16x8*)(bg + (size_t)(RPP * i) * K + (k0)); } while (0)
#define SG_STORE(ra, rbb, buf) do { _Pragma("unroll") for (int i = 0; i < NA; ++i) *(PG8_LAS bf16x8*)(lds + (buf) * BUF + sdst + (RPP * i) * RS) = ra[i]; \
        _Pragma("unroll") for (int i = 0; i < NB; ++i) *(PG8_LAS bf16x8*)(lds + (buf) * BUF + sdst + (128 + RPP * i) * RS) = rbb[i]; } while (0)
#define SG_COMPUTE(buf) do { _Pragma("unroll") for (int s = 0; s < KC / 32; ++s) { \
            const bf16x8 a = *(const PG8_LAS bf16x8*)(lds + (buf) * BUF + fa + s * 64); \
            _Pragma("unroll") for (int j = 0; j < CB; ++j) { const bf16x8 bq = *(const PG8_LAS bf16x8*)(lds + (buf) * BUF + fb + j * 16 * RS + s * 64); \
                acc[j] = __builtin_amdgcn_mfma_f32_16x16x32_bf16(bq, a, acc[j], 0, 0, 0); } } } while (0)
    f32x4 acc[CB];
#pragma unroll
    for (int j = 0; j < CB; ++j) acc[j] = (f32x4){0.f, 0.f, 0.f, 0.f};
    const unsigned fa = (unsigned)((wid * 16 + li) * RS + kg * 16), fb = (unsigned)((128 + li) * RS + kg * 16);
    const int nc = K / KC;
    SG_LOAD(ra0, rb0, 0); SG_LOAD(ra1, rb1, KC); SG_STORE(ra0, rb0, 0);
    SG_BAR();
    for (int c = 0; c < nc; c += 2) {
        if (c + 2 < nc) SG_LOAD(ra0, rb0, (c + 2) * KC);
        SG_COMPUTE(0);
        SG_STORE(ra1, rb1, 1);
        SG_BAR();
        if (c + 3 < nc) SG_LOAD(ra1, rb1, (c + 3) * KC);
        SG_COMPUTE(1);
        if (c + 2 < nc) SG_STORE(ra0, rb0, 0);
        SG_BAR();
    }
#undef SG_LOAD
#undef SG_STORE
#undef SG_COMPUTE
#undef SG_BAR
    const int row = row_base + rb * 128 + wid * 16 + li;
    if constexpr (KIND == 0) {
#pragma unroll
        for (int j = 0; j < CB; ++j) inproj_small(E, row, col0 + 16 * j + 4 * kg, acc[j]);
    } else if constexpr (KIND == 1) {
        typedef unsigned u32x2_t __attribute__((ext_vector_type(2)));
        float s = 0.f;
#pragma unroll
        for (int j = 0; j < CB; ++j) { const size_t off = (size_t)row * 1024 + col0 + 16 * j + 4 * kg;
            const u32x2_t xo = *(const u32x2_t*)(E.xb + off);
            f32x4 x = {bf_lo(xo.x), bf_hi(xo.x), bf_lo(xo.y), bf_hi(xo.y)}; x += acc[j];
            u32x2_t xn; xn.x = cvt_pk_bf16(x[0], x[1]); xn.y = cvt_pk_bf16(x[2], x[3]); *(u32x2_t*)(E.xb + off) = xn;
            const float q0 = bf_lo(xn.x), q1 = bf_hi(xn.x), q2 = bf_lo(xn.y), q3 = bf_hi(xn.y); s += (q0 * q0 + q1 * q1) + (q2 * q2 + q3 * q3); }
        s += swz_xor<16>(s);
        if ((kg & 1) == 0) atomicAdd(E.ss_next + row, s);
    } else {
        typedef unsigned u32x2_t __attribute__((ext_vector_type(2)));
        const float rs = row_rstd(E.ss, row) * E.scale;
#pragma unroll
        for (int j = 0; j < CB; ++j) { f32x4 v = acc[j] * rs;
            if (ACT == 1) {
#pragma unroll
                for (int e2 = 0; e2 < 4; ++e2) { const float a2 = fmaxf(v[e2], 0.f); v[e2] = a2 * a2; } }
            u32x2_t w; w.x = cvt_pk_bf16(v[0], v[1]); w.y = cvt_pk_bf16(v[2], v[3]);
            *(u32x2_t*)(E.O + (size_t)row * E.ldc + col0 + 16 * j + 4 * kg) = w; }
    }
}
}
namespace att {
#define ATT_LAS __attribute__((address_space(3)))
typedef unsigned short bf16_t;
typedef ATT_LAS unsigned char* lptr;
typedef const ATT_LAS unsigned char* clptr;
typedef ATT_LAS float* lfptr;
using bf16x8 = __attribute__((ext_vector_type(8))) short;
using s16x4  = __attribute__((ext_vector_type(4))) short;
using f32x16 = __attribute__((ext_vector_type(16))) float;
using f32x4  = __attribute__((ext_vector_type(4))) float;
using u32x4  = __attribute__((ext_vector_type(4))) unsigned;
#define KSWZ(row, colB) ((row) * 256 + ((colB) ^ (((row) & 7) << 4)))
#define SBAR() __builtin_amdgcn_sched_barrier(0)
constexpr int NROWS_P_ATT = 65536;
constexpr int IMG = 16384;
constexpr float THR = 8.0f;
__device__ __forceinline__ int crow(int r, int hi) { return (r & 3) + 8 * (r >> 2) + 4 * hi; }
__device__ __forceinline__ unsigned cvtpk(float lo, float hi) { unsigned r; asm volatile("v_cvt_pk_bf16_f32 %0, %1, %2" : "=v"(r) : "v"(lo), "v"(hi)); return r; }
__device__ __forceinline__ bf16x8 tobf8(f32x4 a, f32x4 b) { u32x4 w = {cvtpk(a[0], a[1]), cvtpk(a[2], a[3]), cvtpk(b[0], b[1]), cvtpk(b[2], b[3])}; return __builtin_bit_cast(bf16x8, w); }
__device__ __forceinline__ int v_st(int k, int c) { const int kk = (k & ~0xC) | ((k & 4) << 1) | ((k & 8) >> 1); return ((kk >> 3) * 4 + (c >> 5)) * 512 + ((kk & 7) * 32 + (c & 31)) * 2; }
__device__ __forceinline__ int v_rd_base(int lane) { return ((lane & 3) << 3) | (((lane >> 2) & 3) << 6) | (((lane >> 4) & 1) << 5) | (((lane >> 5) & 1) << 8); }
constexpr int v_rd_off(int d0, int ks, int half) { return d0 * 512 + ks * 4096 + half * 2048; }
template <int OFF> __device__ __forceinline__ s16x4 tr_read(int vb) { s16x4 r; asm volatile("ds_read_b64_tr_b16 %0, %1 offset:%2" : "=&v"(r) : "v"(vb), "i"(OFF) : "memory"); return r; }
#define WAITV(n) asm volatile("s_waitcnt vmcnt(" #n ")" ::: "memory")
#define WAITL0() asm volatile("s_waitcnt lgkmcnt(0)" ::: "memory")
#define WGBAR() do { asm volatile("s_waitcnt lgkmcnt(0)" ::: "memory"); __builtin_amdgcn_s_barrier(); asm volatile("" ::: "memory"); } while (0)

__device__ __forceinline__ unsigned k_src_off(int wid, int lane, unsigned rs) { const int row = 4 * wid + (lane >> 4); return (unsigned)row * rs + (unsigned)(((lane & 15) ^ (row & 7)) * 16); }
__device__ __forceinline__ unsigned v_src_off(int wid, int lane, unsigned rs) { const int st = 2 * wid + (lane >> 5), kk = (st >> 2) * 8 + ((lane & 31) >> 2), k = (kk & ~0xC) | ((kk & 4) << 1) | ((kk & 8) >> 1);
    return (unsigned)k * rs + (unsigned)(((st & 3) * 32 + (lane & 3) * 8) * 2); }
__device__ __forceinline__ void dma_img(ATT_LAS unsigned char* dst, const char* src, unsigned off, unsigned rs, int wid) {
    __builtin_amdgcn_global_load_lds((const unsigned*)(src + off), (ATT_LAS unsigned*)(dst + wid * 1024), 16, 0, 0);
    __builtin_amdgcn_global_load_lds((const unsigned*)(src + off + 32u * rs), (ATT_LAS unsigned*)(dst + wid * 1024 + 8192), 16, 0, 0);
}

#define PK4(P, BASE, OUT) do { unsigned a0 = cvtpk(P[BASE + 0], P[BASE + 1]), a1 = cvtpk(P[BASE + 2], P[BASE + 3]);   \
    unsigned b0 = cvtpk(P[BASE + 4], P[BASE + 5]), b1 = cvtpk(P[BASE + 6], P[BASE + 7]);                              \
    auto r0 = __builtin_amdgcn_permlane32_swap(a0, b0, false, false); auto r1 = __builtin_amdgcn_permlane32_swap(a1, b1, false, false); \
    u32x4 w = {r0[0], r1[0], r0[1], r1[1]}; OUT = __builtin_bit_cast(bf16x8, w); } while (0)
__device__ __forceinline__ void sm_tile(f32x16& p0, f32x16& p1, float& m_reg, float& l_reg, float& alpha, bf16x8& pa0, bf16x8& pa1, bf16x8& pa2, bf16x8& pa3) {
    float pmax = p0[0];
#pragma unroll
    for (int r = 1; r < 16; ++r) pmax = fmaxf(pmax, p0[r]);
#pragma unroll
    for (int r = 0; r < 16; ++r) pmax = fmaxf(pmax, p1[r]);
    { auto rr = __builtin_amdgcn_permlane32_swap(__float_as_uint(pmax), __float_as_uint(pmax), false, false); pmax = fmaxf(__uint_as_float(rr[0]), __uint_as_float(rr[1])); }
    float mn;
    if (__builtin_expect(__all(pmax - m_reg <= THR), 1)) { mn = m_reg; alpha = 1.f; }
    else { mn = fmaxf(m_reg, pmax); alpha = __builtin_amdgcn_exp2f(m_reg - mn); m_reg = mn; }
#pragma unroll
    for (int r = 0; r < 16; ++r) p0[r] = __builtin_amdgcn_exp2f(p0[r] - mn);
#pragma unroll
    for (int r = 0; r < 16; ++r) p1[r] = __builtin_amdgcn_exp2f(p1[r] - mn);
    float ps = 0.f;
#pragma unroll
    for (int r = 0; r < 16; ++r) ps += p0[r];
#pragma unroll
    for (int r = 0; r < 16; ++r) ps += p1[r];
    { auto rr = __builtin_amdgcn_permlane32_swap(__float_as_uint(ps), __float_as_uint(ps), false, false); ps = __uint_as_float(rr[0]) + __uint_as_float(rr[1]); }
    l_reg = l_reg * alpha + ps;
    PK4(p0, 0, pa0); PK4(p0, 8, pa1); PK4(p1, 0, pa2); PK4(p1, 8, pa3);
}
template <int D0LO> __device__ __forceinline__ void qkt4(f32x16& p0, f32x16& p1, clptr Ks, const bf16x8* qr, int r32, int hi) {
    p0 = f32x16{}; p1 = f32x16{};
#pragma unroll
    for (int d0 = D0LO; d0 < D0LO + 4; ++d0) { const int cb = (d0 * 16 + hi * 8) * 2;
        const bf16x8 b0 = *(const ATT_LAS bf16x8*)(Ks + KSWZ(r32, cb));
        const bf16x8 b1 = *(const ATT_LAS bf16x8*)(Ks + KSWZ(32 + r32, cb));
        p0 = __builtin_amdgcn_mfma_f32_32x32x16_bf16(b0, qr[d0], p0, 0, 0, 0);
        p1 = __builtin_amdgcn_mfma_f32_32x32x16_bf16(b1, qr[d0], p1, 0, 0, 0); }
}
__device__ __forceinline__ void qkt8_acc(f32x16& p0, f32x16& p1, clptr Ks, const bf16x8* qr, int r32, int hi) {
#pragma unroll
    for (int d0 = 0; d0 < 8; ++d0) { const int cb = (d0 * 16 + hi * 8) * 2;
        const bf16x8 b0 = *(const ATT_LAS bf16x8*)(Ks + KSWZ(r32, cb));
        const bf16x8 b1 = *(const ATT_LAS bf16x8*)(Ks + KSWZ(32 + r32, cb));
        p0 = __builtin_amdgcn_mfma_f32_32x32x16_bf16(b0, qr[d0], p0, 0, 0, 0);
        p1 = __builtin_amdgcn_mfma_f32_32x32x16_bf16(b1, qr[d0], p1, 0, 0, 0); }
}
#define PKV(L, H) (bf16x8){L[0], L[1], L[2], L[3], H[0], H[1], H[2], H[3]}
template <int D0> __device__ __forceinline__ void pv2_one(f32x16& oa, f32x16& ob, int vb, const bf16x8* pa, const bf16x8* pb) {
    const s16x4 l0 = tr_read<v_rd_off(D0, 0, 0)>(vb), h0 = tr_read<v_rd_off(D0, 0, 1)>(vb), l1 = tr_read<v_rd_off(D0, 1, 0)>(vb), h1 = tr_read<v_rd_off(D0, 1, 1)>(vb);
    const s16x4 l2 = tr_read<v_rd_off(D0, 2, 0)>(vb), h2 = tr_read<v_rd_off(D0, 2, 1)>(vb), l3 = tr_read<v_rd_off(D0, 3, 0)>(vb), h3 = tr_read<v_rd_off(D0, 3, 1)>(vb);
    asm volatile("s_waitcnt lgkmcnt(0)" ::: "memory"); SBAR();
    const bf16x8 v0 = PKV(l0, h0), v1 = PKV(l1, h1), v2 = PKV(l2, h2), v3 = PKV(l3, h3);
    oa = __builtin_amdgcn_mfma_f32_32x32x16_bf16(pa[0], v0, oa, 0, 0, 0); ob = __builtin_amdgcn_mfma_f32_32x32x16_bf16(pb[0], v0, ob, 0, 0, 0);
    oa = __builtin_amdgcn_mfma_f32_32x32x16_bf16(pa[1], v1, oa, 0, 0, 0); ob = __builtin_amdgcn_mfma_f32_32x32x16_bf16(pb[1], v1, ob, 0, 0, 0);
    oa = __builtin_amdgcn_mfma_f32_32x32x16_bf16(pa[2], v2, oa, 0, 0, 0); ob = __builtin_amdgcn_mfma_f32_32x32x16_bf16(pb[2], v2, ob, 0, 0, 0);
    oa = __builtin_amdgcn_mfma_f32_32x32x16_bf16(pa[3], v3, oa, 0, 0, 0); ob = __builtin_amdgcn_mfma_f32_32x32x16_bf16(pb[3], v3, ob, 0, 0, 0);
}
template <int D0> __device__ __forceinline__ void pv1_one(f32x16& oa, int vb, const bf16x8* pa) {
    const s16x4 l0 = tr_read<v_rd_off(D0, 0, 0)>(vb), h0 = tr_read<v_rd_off(D0, 0, 1)>(vb), l1 = tr_read<v_rd_off(D0, 1, 0)>(vb), h1 = tr_read<v_rd_off(D0, 1, 1)>(vb);
    const s16x4 l2 = tr_read<v_rd_off(D0, 2, 0)>(vb), h2 = tr_read<v_rd_off(D0, 2, 1)>(vb), l3 = tr_read<v_rd_off(D0, 3, 0)>(vb), h3 = tr_read<v_rd_off(D0, 3, 1)>(vb);
    asm volatile("s_waitcnt lgkmcnt(0)" ::: "memory"); SBAR();
    oa = __builtin_amdgcn_mfma_f32_32x32x16_bf16(pa[0], PKV(l0, h0), oa, 0, 0, 0);
    oa = __builtin_amdgcn_mfma_f32_32x32x16_bf16(pa[1], PKV(l1, h1), oa, 0, 0, 0);
    oa = __builtin_amdgcn_mfma_f32_32x32x16_bf16(pa[2], PKV(l2, h2), oa, 0, 0, 0);
    oa = __builtin_amdgcn_mfma_f32_32x32x16_bf16(pa[3], PKV(l3, h3), oa, 0, 0, 0);
}

struct VSet { s16x4 l0, h0, l1, h1, l2, h2, l3, h3; };
typedef short v4i16_t __attribute__((ext_vector_type(4)));
template <int OFF> __device__ __forceinline__ s16x4 tr_read_b(int vb) {
    return __builtin_bit_cast(s16x4, __builtin_amdgcn_ds_read_tr16_b64_v4i16((ATT_LAS v4i16_t*)(uintptr_t)(unsigned)(vb + OFF))); }
template <int D0> __device__ __forceinline__ void v_issue(VSet& v, int vb) {
    v.l0 = tr_read_b<v_rd_off(D0, 0, 0)>(vb); v.h0 = tr_read_b<v_rd_off(D0, 0, 1)>(vb); v.l1 = tr_read_b<v_rd_off(D0, 1, 0)>(vb); v.h1 = tr_read_b<v_rd_off(D0, 1, 1)>(vb);
    v.l2 = tr_read_b<v_rd_off(D0, 2, 0)>(vb); v.h2 = tr_read_b<v_rd_off(D0, 2, 1)>(vb); v.l3 = tr_read_b<v_rd_off(D0, 3, 0)>(vb); v.h3 = tr_read_b<v_rd_off(D0, 3, 1)>(vb);
}
__device__ __forceinline__ void v_mma(f32x16& oa, const VSet& v, const bf16x8* pa) {
    oa = __builtin_amdgcn_mfma_f32_32x32x16_bf16(pa[0], PKV(v.l0, v.h0), oa, 0, 0, 0);
    oa = __builtin_amdgcn_mfma_f32_32x32x16_bf16(pa[1], PKV(v.l1, v.h1), oa, 0, 0, 0);
    oa = __builtin_amdgcn_mfma_f32_32x32x16_bf16(pa[2], PKV(v.l2, v.h2), oa, 0, 0, 0);
    oa = __builtin_amdgcn_mfma_f32_32x32x16_bf16(pa[3], PKV(v.l3, v.h3), oa, 0, 0, 0);
}
#define WAITL(n) asm volatile("s_waitcnt lgkmcnt(" #n ")" ::: "memory")
__device__ __forceinline__ void pv_pipe(f32x16* o, int vb, const bf16x8* pa, VSet& A, VSet& B) {
    SBAR(); v_mma(o[0], A, pa); v_issue<2>(A, vb); SBAR();
    v_mma(o[1], B, pa); v_issue<3>(B, vb); SBAR();
    v_mma(o[2], A, pa); SBAR();
    v_mma(o[3], B, pa); SBAR();
}
constexpr int WSF_OFF = 131072 + 1024;
constexpr int Q_OFF = 98304;
constexpr int SLOT = 32768;
struct FState { f32x16 o[4]; f32x16 negm; float m, l; };
__device__ __forceinline__ void partialSM_first(f32x16& p0, f32x16& p1, float& m_reg, f32x16& negm) {
    float pmax = p0[0];
#pragma unroll
    for (int r = 1; r < 16; ++r) pmax = fmaxf(pmax, p0[r]);
#pragma unroll
    for (int r = 0; r < 16; ++r) pmax = fmaxf(pmax, p1[r]);
    { auto rr = __builtin_amdgcn_permlane32_swap(__float_as_uint(pmax), __float_as_uint(pmax), false, false); pmax = fmaxf(__uint_as_float(rr[0]), __uint_as_float(rr[1])); }
    m_reg = pmax;
#pragma unroll
    for (int r = 0; r < 16; ++r) negm[r] = -pmax;
    asm volatile("" : "+v"(negm));
#pragma unroll
    for (int r = 0; r < 16; ++r) { p0[r] -= pmax; p1[r] -= pmax; }
#pragma unroll
    for (int r = 0; r < 16; ++r) p0[r] = __builtin_amdgcn_exp2f(p0[r]);
}
__device__ __forceinline__ void partialSM(f32x16& p0, f32x16& p1, float& m_reg, float& alpha, f32x16& negm) {
    float pmax = p0[0];
#pragma unroll
    for (int r = 1; r < 16; ++r) pmax = fmaxf(pmax, p0[r]);
#pragma unroll
    for (int r = 0; r < 16; ++r) pmax = fmaxf(pmax, p1[r]);
    { auto rr = __builtin_amdgcn_permlane32_swap(__float_as_uint(pmax), __float_as_uint(pmax), false, false); pmax = fmaxf(__uint_as_float(rr[0]), __uint_as_float(rr[1])); }
    if (__builtin_expect(__all(pmax <= THR), 1)) { alpha = 1.f; }
    else { const float dl = fmaxf(pmax, 0.f); m_reg += dl; alpha = __builtin_amdgcn_exp2f(-dl);
#pragma unroll
        for (int r = 0; r < 16; ++r) { p0[r] -= dl; p1[r] -= dl; negm[r] = -m_reg; }
        asm volatile("" : "+v"(negm)); }
#pragma unroll
    for (int r = 0; r < 16; ++r) p0[r] = __builtin_amdgcn_exp2f(p0[r]);
}
__device__ __forceinline__ void finishSM(f32x16& p0, f32x16& p1, float alpha, float& l_reg, bf16x8* pa) {
#pragma unroll
    for (int r = 0; r < 16; ++r) p1[r] = __builtin_amdgcn_exp2f(p1[r]);
    float ps = 0.f;
#pragma unroll
    for (int r = 0; r < 16; ++r) ps += p0[r];
#pragma unroll
    for (int r = 0; r < 16; ++r) ps += p1[r];
    { auto rr = __builtin_amdgcn_permlane32_swap(__float_as_uint(ps), __float_as_uint(ps), false, false); ps = __uint_as_float(rr[0]) + __uint_as_float(rr[1]); }
    l_reg = l_reg * alpha + ps;
    PK4(p0, 0, pa[0]); PK4(p0, 8, pa[1]); PK4(p1, 0, pa[2]); PK4(p1, 8, pa[3]);
}
__device__ __forceinline__ void qkt64(f32x16& p0, f32x16& p1, clptr Ks, clptr qr  , const f32x16& cin  , int r32, int hi) {
#pragma unroll
    for (int d0 = 0; d0 < 4; ++d0) { const int cb = (d0 * 16 + hi * 8) * 2;
        const bf16x8 b0 = *(const ATT_LAS bf16x8*)(Ks + KSWZ(r32, cb));
        const bf16x8 b1 = *(const ATT_LAS bf16x8*)(Ks + KSWZ(32 + r32, cb));
        const bf16x8 q = *(const ATT_LAS bf16x8*)(qr + d0 * 1024);
        if (d0 == 0) { p0 = __builtin_amdgcn_mfma_f32_32x32x16_bf16(b0, q, cin, 0, 0, 0); p1 = __builtin_amdgcn_mfma_f32_32x32x16_bf16(b1, q, cin, 0, 0, 0); }
        else { p0 = __builtin_amdgcn_mfma_f32_32x32x16_bf16(b0, q, p0, 0, 0, 0); p1 = __builtin_amdgcn_mfma_f32_32x32x16_bf16(b1, q, p1, 0, 0, 0); } }
}
__device__ __forceinline__ void pv_all(f32x16* o, int vb, const bf16x8* pa) { pv1_one<0>(o[0], vb, pa); pv1_one<1>(o[1], vb, pa); pv1_one<2>(o[2], vb, pa); pv1_one<3>(o[3], vb, pa); }
__device__ __forceinline__ void resc(f32x16* o, float a, lfptr wsf, int r32, int hi) {
    if (__any(a < 1.f)) { if (hi == 0) wsf[r32] = a; WAITL0();
#pragma unroll
        for (int r = 0; r < 16; ++r) { const float f = wsf[crow(r, hi)];
#pragma unroll
            for (int d = 0; d < 4; ++d) o[d][r] *= f; }
        WAITL0(); }
}
#define PV_TILE(vb_) pv_all(S.o, (vb_), pa)
#define FLASH_LOOP(NT_, MASKLAST_, SYNC_, LATE_) do { \
    f32x16 pA0, pA1, pB0, pB1; float alA, alB; bf16x8 pa[4]; \
    int sK = 0, sV = 0;                                   \
    SYNC_(0); LATE_(0); \
    qkt64(pA0, pA1, kbase + sK, qr, S.negm, r32, hi); partialSM_first(pA0, pA1, S.m, S.negm); alA = 1.f; \
    int t = 1; \
    for (; t + 1 < (NT_); t += 2) { \
        sV = sK; sK = (sK == 2 * SLOT) ? 0 : sK + SLOT; SYNC_(t); \
        SBAR(); qkt64(pB0, pB1, kbase + sK, qr, S.negm, r32, hi); LATE_(t); finishSM(pA0, pA1, alA, S.l, pa); SBAR(); \
        PV_TILE(vbase + sV); partialSM(pB0, pB1, S.m, alB, S.negm); resc(S.o, alB, wsf, r32, hi); \
        sV = sK; sK = (sK == 2 * SLOT) ? 0 : sK + SLOT; SYNC_(t + 1); \
        SBAR(); qkt64(pA0, pA1, kbase + sK, qr, S.negm, r32, hi); LATE_(t + 1); finishSM(pB0, pB1, alB, S.l, pa); SBAR(); \
        PV_TILE(vbase + sV); partialSM(pA0, pA1, S.m, alA, S.negm); resc(S.o, alA, wsf, r32, hi); \
    } \
    if (t < (NT_)) { \
        sV = sK; sK = (sK == 2 * SLOT) ? 0 : sK + SLOT; SYNC_(t); \
        SBAR(); qkt64(pB0, pB1, kbase + sK, qr, S.negm, r32, hi); LATE_(t); \
        if (MASKLAST_) { _Pragma("unroll") for (int r = 0; r < 16; ++r) { pB0[r] = -1e30f; pB1[r] = -1e30f; } } \
        finishSM(pA0, pA1, alA, S.l, pa); SBAR(); \
        PV_TILE(vbase + sV); partialSM(pB0, pB1, S.m, alB, S.negm); resc(S.o, alB, wsf, r32, hi); \
        finishSM(pB0, pB1, alB, S.l, pa); SBAR(); PV_TILE(vbase + sK); \
    } else { \
        finishSM(pA0, pA1, alA, S.l, pa); SBAR(); PV_TILE(vbase + sK); \
    } } while (0)

#define FLASH_LOOP_B(NT_, MASKLAST_, SYNC_, LATE_) do { \
    f32x16 pA0, pA1, pB0, pB1; float alA, alB; bf16x8 pa[4]; \
    int sK = 0, sV = 0; \
    SYNC_(0); LATE_(0); \
    qkt64(pA0, pA1, kbase + sK, qr, S.negm, r32, hi); partialSM_first(pA0, pA1, S.m, S.negm); alA = 1.f; \
    int t = 1; \
    for (; t + 1 < (NT_); t += 2) { \
        sV = sK; sK = (sK == 2 * SLOT) ? 0 : sK + SLOT; SYNC_(t); \
        SBAR(); finishSM(pA0, pA1, alA, S.l, pa); SBAR(); LATE_(t); qkt64(pB0, pB1, kbase + sK, qr, S.negm, r32, hi); SBAR(); partialSM(pB0, pB1, S.m, alB, S.negm); SBAR(); \
        PV_TILE(vbase + sV); resc(S.o, alB, wsf, r32, hi); \
        sV = sK; sK = (sK == 2 * SLOT) ? 0 : sK + SLOT; SYNC_(t + 1); \
        SBAR(); finishSM(pB0, pB1, alB, S.l, pa); SBAR(); LATE_(t + 1); qkt64(pA0, pA1, kbase + sK, qr, S.negm, r32, hi); SBAR(); partialSM(pA0, pA1, S.m, alA, S.negm); SBAR(); \
        PV_TILE(vbase + sV); resc(S.o, alA, wsf, r32, hi); \
    } \
    if (t < (NT_)) { \
        sV = sK; sK = (sK == 2 * SLOT) ? 0 : sK + SLOT; SYNC_(t); \
        SBAR(); finishSM(pA0, pA1, alA, S.l, pa); SBAR(); LATE_(t); qkt64(pB0, pB1, kbase + sK, qr, S.negm, r32, hi); SBAR(); \
        if (MASKLAST_) { _Pragma("unroll") for (int r = 0; r < 16; ++r) { pB0[r] = -1e30f; pB1[r] = -1e30f; } } \
        partialSM(pB0, pB1, S.m, alB, S.negm); SBAR(); \
        PV_TILE(vbase + sV); resc(S.o, alB, wsf, r32, hi); \
        finishSM(pB0, pB1, alB, S.l, pa); SBAR(); PV_TILE(vbase + sK); \
    } else { \
        finishSM(pA0, pA1, alA, S.l, pa); SBAR(); PV_TILE(vbase + sK); \
    } } while (0)

__device__ __forceinline__ void diff_finish2(FState& S, lptr lds, int map, int qblk, bool active, float lam, float post_scale, const float* subg, bf16_t* outp  ,
                                             lfptr wsf, int lane, int r32, int hi) {
    lfptr stash = (lfptr)lds + qblk * 4096 + lane;
    if (active && map == 1) {
        if (hi == 0) wsf[r32] = lam / S.l;
        WAITL0();
#pragma unroll
        for (int r = 0; r < 16; ++r) { const float f = wsf[crow(r, hi)];
#pragma unroll
            for (int d = 0; d < 4; ++d) stash[(d * 16 + r) * 64] = S.o[d][r] * f; }
    }
    WGBAR();
    if (active && map == 0) {
        if (hi == 0) wsf[r32] = 1.0f / S.l;
        WAITL0();
        float g[4];
#pragma unroll
        for (int d = 0; d < 4; ++d) g[d] = subg[32 * d + r32] * post_scale;
        unsigned lane_off = (unsigned)(4 * hi) * (unsigned)ZLD + (unsigned)r32;
#pragma unroll
        for (int r = 0; r < 16; ++r) {
            asm volatile("" : "+v"(lane_off));
            const float c1 = wsf[crow(r, hi)];
            float v[4]; float ss = 0.f;
#pragma unroll
            for (int d = 0; d < 4; ++d) { v[d] = S.o[d][r] * c1 - stash[(d * 16 + r) * 64]; ss += v[d] * v[d]; }
            ss = xsum32(ss);
            const float rs = 1.0f / sqrtf(ss * (1.0f / 128.0f) + 1e-5f);
#pragma unroll
            for (int d = 0; d < 4; ++d) { const __hip_bfloat16 hb = __float2bfloat16(v[d] * rs * g[d]); outp[lane_off + (unsigned)(((r & 3) + 8 * (r >> 2)) * ZLD + 32 * d)] = __builtin_bit_cast(unsigned short, hb); }
        }
    }
    WAITV(0); WGBAR();
}

__device__ __forceinline__ void diff_prompt_unit(lptr lds, const bf16_t* Qa, const bf16_t* Ka, const bf16_t* Va, bf16_t* mix, int b, int h, int qb, float lam, float post_scale, const float* subg) {
    int tid = threadIdx.x; asm volatile("" : "+v"(tid));
    const int lane = tid & 63, r32 = lane & 31, hi = lane >> 5; const int wid = __builtin_amdgcn_readfirstlane(tid >> 6);
    const int map = wid >> 2, qblk = wid & 3;
    const size_t rowbase = (size_t)b * 8192; const int q0 = qb * 128;
    lfptr wsf = (lfptr)(lds + WSF_OFF) + wid * 64;
    const unsigned koff = k_src_off(wid, lane, 2u * ZLD), voff = v_src_off(wid, lane, 2u * ZLD);
    const char* Kg = (const char*)(Ka + rowbase * ZLD + h * 128); const char* Vg = (const char*)(Va + rowbase * ZLD + h * 128);
    const int NT = 2 * qb + 2; const bool masklast = (qblk >> 1) == 0;
    const lptr qr = lds + Q_OFF + wid * 4096 + lane * 16;
    { const bf16_t* Qw = Qa + (rowbase + q0 + qblk * 32 + r32) * ZLD + h * 128 + map * 64 + hi * 8;
#pragma unroll
      for (int d0 = 0; d0 < 4; ++d0) *(ATT_LAS bf16x8*)(qr + d0 * 1024) = *reinterpret_cast<const bf16x8*>(Qw + d0 * 16); }
    WAITV(0);
#define DMA_TILE(t, sofs) do { dma_img(lds + (sofs), Kg + (size_t)(t) * (128 * ZLD), koff, 2u * ZLD, wid); dma_img(lds + (sofs) + IMG, Vg + (size_t)(t) * (128 * ZLD), voff, 2u * ZLD, wid); } while (0)
    DMA_TILE(0, 0);
    FState S;
#pragma unroll
    for (int d = 0; d < 4; ++d) S.o[d] = f32x16{};
    S.negm = f32x16{}; S.m = 0.f; S.l = 0.f;
    const clptr kbase = lds + map * 128;
    const int vbase = (int)(unsigned)(uintptr_t)(lds + IMG) + v_rd_base(lane);
#define SYNC_W(t) do { WAITV(0); WGBAR(); } while (0)
#define SYNC_D(t) do { if ((t) + 1 < NT) { const int sn_ = (sK == 2 * SLOT) ? 0 : sK + SLOT; DMA_TILE((t) + 1, sn_); } } while (0)
#define SYNC_P(t) do { SYNC_W(t); SYNC_D(t); } while (0)
    if ((((wid >> 2) ^ wid) & 1) == 0) FLASH_LOOP(NT, masklast, SYNC_W, SYNC_D);
    else FLASH_LOOP_B(NT, masklast, SYNC_W, SYNC_D);
#undef SYNC_P
#undef SYNC_W
#undef SYNC_D
#undef DMA_TILE
    WGBAR();
    diff_finish2(S, lds, map, qblk, true, lam, post_scale, subg, mix + (rowbase + q0 + qblk * 32) * ZLD + h * 128, wsf, lane, r32, hi);
}

__device__ __forceinline__ void diff_sample_unit(lptr lds, const bf16_t* Qa, const bf16_t* Ka, const bf16_t* Va, const float* ck, const float* cv, bf16_t* mix, int b, int h, float lam, float post_scale, const float* subg) {
    int tid = threadIdx.x; asm volatile("" : "+v"(tid));
    const int lane = tid & 63, r32 = lane & 31, hi = lane >> 5; const int wid = __builtin_amdgcn_readfirstlane(tid >> 6);
    const int map = wid >> 2, qblk = wid & 3;
    const size_t row0 = (size_t)NROWS_P_ATT + (size_t)b * 64;
    lfptr wsf = (lfptr)(lds + WSF_OFF) + wid * 64;
    constexpr int NT = 33;
    const float* ckb = ck + (size_t)b * 2048 * 512; const float* cvb = cv + (size_t)b * 2048 * 512;
    FState S;
#define S_ZERO() do { _Pragma("unroll") for (int d = 0; d < 4; ++d) S.o[d] = f32x16{}; S.negm = f32x16{}; S.m = 0.f; S.l = 0.f; } while (0)
    if (wid & 2) {
        int lt = (wid >> 2) * 128 + (tid & 127); asm volatile("" : "+v"(lt));
        const int sr = lt >> 4, sc = (lt & 15) * 8;
        const unsigned kofs = (unsigned)sr * 512u + (unsigned)((sc >> 6) * 256 + h * 64 + (sc & 63));
        const unsigned vofs = (unsigned)sr * 512u + (unsigned)(h * 128 + sc);
        const unsigned kst = (unsigned)KSWZ(sr, sc * 2);
        f32x4 kr0[4][2], vr0[4][2], kr1[4][2], vr1[4][2];
#define LD_TILE(kr, vr, t) do { const float* kt_ = ckb + (size_t)(t) * 64 * 512; const float* vt_ = cvb + (size_t)(t) * 64 * 512; \
            _Pragma("unroll") for (int j = 0; j < 4; ++j) { const float* kp = kt_ + (kofs + (unsigned)(j * 16 * 512)); const float* vp = vt_ + (vofs + (unsigned)(j * 16 * 512)); \
                kr[j][0] = *(const f32x4*)kp; kr[j][1] = *(const f32x4*)(kp + 4); vr[j][0] = *(const f32x4*)vp; vr[j][1] = *(const f32x4*)(vp + 4); } } while (0)
#define ST_TILE(kr, vr, sofs) do { _Pragma("unroll") for (int j = 0; j < 4; ++j) { \
                *(ATT_LAS bf16x8*)(lds + (sofs) + kst + j * 4096) = tobf8(kr[j][0], kr[j][1]); *(ATT_LAS bf16x8*)(lds + (sofs) + IMG + v_st(sr + 16 * j, sc)) = tobf8(vr[j][0], vr[j][1]); } } while (0)
#define NEXT_SLOT(x) ((x) == 2 * SLOT ? 0 : (x) + SLOT)
        LD_TILE(kr0, vr0, 0); ST_TILE(kr0, vr0, 0); LD_TILE(kr1, vr1, 1); LD_TILE(kr0, vr0, 2);
        WGBAR();
        int sofs = SLOT;
        for (int t = 1; t < 31; t += 2) {
            ST_TILE(kr1, vr1, sofs); if (t + 2 < 32) LD_TILE(kr1, vr1, t + 2); sofs = NEXT_SLOT(sofs);
            WGBAR();
            ST_TILE(kr0, vr0, sofs); if (t + 3 < 32) LD_TILE(kr0, vr0, t + 3); sofs = NEXT_SLOT(sofs);
            WGBAR();
        }
        ST_TILE(kr1, vr1, sofs); sofs = NEXT_SLOT(sofs);
        WGBAR();
        { const bf16_t* kn = Ka + row0 * ZLD; const bf16_t* vn = Va + row0 * ZLD;
#pragma unroll
            for (int j = 0; j < 4; ++j) { const unsigned o = (unsigned)(sr + 16 * j) * (unsigned)ZLD + (unsigned)(h * 128 + sc);
                *(ATT_LAS bf16x8*)(lds + sofs + kst + j * 4096) = *(const bf16x8*)(kn + o);
                *(ATT_LAS bf16x8*)(lds + sofs + IMG + v_st(sr + 16 * j, sc)) = *(const bf16x8*)(vn + o); } }
        WGBAR();
#undef NEXT_SLOT
#undef LD_TILE
#undef ST_TILE
        S_ZERO();
    } else {
        S_ZERO();
        const lptr qr = lds + Q_OFF + wid * 4096 + lane * 16;
        { const bf16_t* Qw = Qa + (row0 + (qblk & 1) * 32 + r32) * ZLD + h * 128 + map * 64 + hi * 8;
#pragma unroll
          for (int d0 = 0; d0 < 4; ++d0) *(ATT_LAS bf16x8*)(qr + d0 * 1024) = *reinterpret_cast<const bf16x8*>(Qw + d0 * 16); }
        const clptr kbase = lds + map * 128;
        const int vbase = (int)(unsigned)(uintptr_t)(lds + IMG) + v_rd_base(lane);
#define SYNC_S(t) do { WGBAR(); } while (0)
#define SYNC_N(t) do { } while (0)
        if (map == 0) FLASH_LOOP(NT, false, SYNC_S, SYNC_N); else FLASH_LOOP_B(NT, false, SYNC_S, SYNC_N);
#undef SYNC_N
#undef SYNC_S
    }
    WGBAR();
    diff_finish2(S, lds, map, qblk, (wid & 2) == 0, lam, post_scale, subg, mix + (row0 + (qblk & 1) * 32) * ZLD + h * 128, wsf, lane, r32, hi);
}

template <int NACT> __device__ __forceinline__ void cross_unit(lptr lds, const bf16_t* Qrows  , const bf16_t* MK, const bf16_t* MV, bf16_t* Orows, int h) {
    int tid = threadIdx.x; asm volatile("" : "+v"(tid));
    const int lane = tid & 63, r32 = lane & 31, hi = lane >> 5; const int wid = __builtin_amdgcn_readfirstlane(tid >> 6);
    lfptr wsf = (lfptr)(lds + WSF_OFF) + wid * 64;
    const unsigned koff = k_src_off(wid, lane, 2048u), voff = v_src_off(wid, lane, 2048u);
    const char* Kg = (const char*)(MK + h * 256); const char* Vg = (const char*)(MV + h * 256);
    lptr l3 = lds;
    const bool act = wid < NACT;
    bf16x8 qr[16];
    if (act) { const bf16_t* Qw = Qrows + (size_t)(wid * 32 + r32) * ZLD + h * 256 + hi * 8;
#pragma unroll
        for (int d0 = 0; d0 < 16; ++d0) qr[d0] = *reinterpret_cast<const bf16x8*>(Qw + d0 * 16); }
    else {
#pragma unroll
        for (int d0 = 0; d0 < 16; ++d0) qr[d0] = bf16x8{}; }
#define X_DMA(idx) do { if ((idx) < 8) dma_img(l3 + ((idx) & 3) * IMG, Kg + (size_t)((idx) >> 1) * 64 * 2048 + ((idx) & 1) * 256, koff, 2048u, wid); \
                        else dma_img(l3 + ((idx) & 3) * IMG, Vg + (size_t)(((idx) - 8) & 3) * 64 * 2048 + (((idx) - 8) >> 2) * 256, voff, 2048u, wid); } while (0)
    X_DMA(0); X_DMA(1); X_DMA(2);
    f32x16 s[4][2];
#pragma unroll
    for (int kt = 0; kt < 4; ++kt) { s[kt][0] = f32x16{}; s[kt][1] = f32x16{}; }
#define X_STEP_K(idx) do { WAITV(4); WGBAR(); X_DMA((idx) + 3); if (act) qkt8_acc(s[(idx) >> 1][0], s[(idx) >> 1][1], lds + ((idx) & 3) * IMG, qr + ((idx) & 1) * 8, r32, hi); } while (0)
    X_STEP_K(0); X_STEP_K(1); X_STEP_K(2); X_STEP_K(3); X_STEP_K(4); X_STEP_K(5); X_STEP_K(6); X_STEP_K(7);
#undef X_STEP_K
    bf16x8 pa[4][4]; float inv;
    {
        float pmax = s[0][0][0];
#pragma unroll
        for (int kt = 0; kt < 4; ++kt)
#pragma unroll
            for (int j = 0; j < 2; ++j)
#pragma unroll
                for (int r = 0; r < 16; ++r) pmax = fmaxf(pmax, s[kt][j][r]);
        { auto rr = __builtin_amdgcn_permlane32_swap(__float_as_uint(pmax), __float_as_uint(pmax), false, false); pmax = fmaxf(__uint_as_float(rr[0]), __uint_as_float(rr[1])); }
        float ps = 0.f;
#pragma unroll
        for (int kt = 0; kt < 4; ++kt)
#pragma unroll
            for (int j = 0; j < 2; ++j)
#pragma unroll
                for (int r = 0; r < 16; ++r) { const float e = __builtin_amdgcn_exp2f(s[kt][j][r] - pmax); s[kt][j][r] = e; ps += e; }
        { auto rr = __builtin_amdgcn_permlane32_swap(__float_as_uint(ps), __float_as_uint(ps), false, false); ps = __uint_as_float(rr[0]) + __uint_as_float(rr[1]); }
        inv = 1.0f / ps;
#pragma unroll
        for (int kt = 0; kt < 4; ++kt) { PK4(s[kt][0], 0, pa[kt][0]); PK4(s[kt][0], 8, pa[kt][1]); PK4(s[kt][1], 0, pa[kt][2]); PK4(s[kt][1], 8, pa[kt][3]); }
    }
    WAITL0();
    if (hi == 0) wsf[r32] = inv;
    WAITL0();
    float rli[16];
#pragma unroll
    for (int r = 0; r < 16; ++r) rli[r] = wsf[crow(r, hi)];
    const int vb0 = (int)(unsigned)(uintptr_t)lds + v_rd_base(lane);
    f32x16 o[4];
#define X_STEP_V(idx, WN) do { WAITV(WN); WGBAR(); if ((idx) + 3 < 16) X_DMA((idx) + 3); \
        if ((((idx) - 8) & 3) == 0) { o[0] = f32x16{}; o[1] = f32x16{}; o[2] = f32x16{}; o[3] = f32x16{}; } \
        if (act) { const int vb_ = vb0 + ((idx) & 3) * IMG; const bf16x8* pp_ = pa[((idx) - 8) & 3]; pv1_one<0>(o[0], vb_, pp_); pv1_one<1>(o[1], vb_, pp_); pv1_one<2>(o[2], vb_, pp_); pv1_one<3>(o[3], vb_, pp_); \
            if ((((idx) - 8) & 3) == 3) { bf16_t* op_ = Orows + (size_t)(wid * 32) * ZLD + h * 256 + (((idx) - 8) >> 2) * 128; \
                _Pragma("unroll") for (int r = 0; r < 16; ++r) { const int orow = crow(r, hi); \
                    _Pragma("unroll") for (int d = 0; d < 4; ++d) { const __hip_bfloat16 hb = __float2bfloat16(o[d][r] * rli[r]); op_[(size_t)orow * ZLD + 32 * d + r32] = __builtin_bit_cast(unsigned short, hb); } } } } } while (0)
    X_STEP_V(8, 4); X_STEP_V(9, 4); X_STEP_V(10, 4); X_STEP_V(11, 4); X_STEP_V(12, 4); X_STEP_V(13, 4); X_STEP_V(14, 2); X_STEP_V(15, 0);
#undef X_STEP_V
#undef X_DMA
}
#undef PK4
}

constexpr int NWAVES = 8;
#ifndef MK_PER_PHASE
#define MK_PER_PHASE 0
#endif
constexpr int DM = 1024, BATCH = 8, SEQ = 8192, DEPTH = 2, DEC_BATCH = 32, DEC_SEQ = 64, PAST = 2048, NMEM = 256, DFF = 4096;
constexpr int MP = BATCH * SEQ, MS = DEC_BATCH * DEC_SEQ, MT = MP + MS;
constexpr int NPH = 18;
constexpr size_t O_YP = 0, O_YS = O_YP + (size_t)MP * DM, O_KP = O_YS + (size_t)MS * DM, O_VP = O_KP + (size_t)DEPTH * MP * 512, O_PP = O_VP + (size_t)DEPTH * MP * 512,
                 O_MKP = O_PP + (size_t)DEPTH * BATCH * 15 * 512, O_MVP = O_MKP + (size_t)DEPTH * BATCH * NMEM * DM, O_KS = O_MVP + (size_t)DEPTH * BATCH * NMEM * DM,
                 O_VS = O_KS + (size_t)DEPTH * MS * 512, O_PS = O_VS + (size_t)DEPTH * MS * 512, O_END = O_PS + (size_t)DEPTH * DEC_BATCH * 15 * 512;
constexpr size_t MiB = 1u << 20;
constexpr size_t WS_CTL = 0, CTL_ZERO_BYTES = 4 * MiB;
constexpr size_t WS_SS = 1 * MiB;
constexpr size_t WS_W = 4 * MiB;
constexpr size_t W_IN = 0, W_OUT = 4 * MiB, W_Q = 6 * MiB, W_O = 8 * MiB, W_UP = 10 * MiB, W_DOWN = 18 * MiB, W_LAYER = 26 * MiB, W_KV = 52 * MiB;
constexpr size_t WS_MEMB = 64 * MiB;
constexpr size_t WS_MKP = 68 * MiB, WS_MVP = 76 * MiB;
constexpr size_t WS_MKS = 84 * MiB, WS_MVS = 116 * MiB;
constexpr size_t WS_XB = 148 * MiB;
constexpr size_t WS_Z = 280 * MiB;
constexpr int ZC_QA = 0, ZC_KA = 512, ZC_VA = 1024, ZC_U = 1536, ZC_MIX = 2048, ZC_QX = 0, ZC_OX = 1024;
constexpr size_t WS_END = WS_Z + 528 * MiB;
static_assert((size_t)MT * 512 * 2 == 66 * MiB && (size_t)MT * 4096 * 2 == 528 * MiB, "region sizes");
constexpr int CW_BAR = 4096;
constexpr int CW_TICKET = 16384;
constexpr int RING_BYTES = 131072, LDSCTL_OFF = RING_BYTES, MISC_OFF = LDSCTL_OFF + 320, LDS_BYTES = 147456;

#define GAS __attribute__((address_space(1)))
#define LAS __attribute__((address_space(3)))
typedef unsigned short bf16;
typedef unsigned v4u __attribute__((ext_vector_type(4)));
typedef float f32x4 __attribute__((ext_vector_type(4)));
typedef GAS unsigned gu32;
#define LDS_WAIT() asm volatile("s_waitcnt lgkmcnt(0)" ::: "memory")
#define VM_WAIT() asm volatile("s_waitcnt vmcnt(0)" ::: "memory")
__device__ __forceinline__ unsigned f2bf(float f) { unsigned u = __builtin_bit_cast(unsigned, f); return (u + 0x7fffu + ((u >> 16) & 1u)) >> 16; }
__device__ __forceinline__ unsigned pk2(float lo, float hi) { return f2bf(lo) | (f2bf(hi) << 16); }
__device__ __forceinline__ float bf2f(unsigned short h) { return __builtin_bit_cast(float, (unsigned)h << 16); }
#define XB_TMO      128
#define XB_XCNT(j)  (256  + 64 * (j))
#define XB_XSUB(j)  (1280 + 64 * (j))
#define XB_XGEN(j)  (2304 + 64 * (j))
#define XB_TOP      3328
#define XB_TOPGEN   3392
#define XB_XLOC(j)  (3456 + 64 * (j))
#define XCD_BAR_WORDS 4480
#define XB_SPIN_CAP (1u << 18)

__device__ __forceinline__ unsigned xb_ld(unsigned* p)              { return __hip_atomic_load(p, __ATOMIC_RELAXED, __HIP_MEMORY_SCOPE_AGENT); }
__device__ __forceinline__ unsigned xb_add(unsigned* p, unsigned v) { return __hip_atomic_fetch_add(p, v, __ATOMIC_RELAXED, __HIP_MEMORY_SCOPE_AGENT); }
__device__ __forceinline__ unsigned xb_xcc_id() { return (unsigned)__builtin_amdgcn_s_getreg((3 << 11) | 20) & 0xFu; }
#define XB_SPIN(cond, bar) do { unsigned _sp = 0; while (cond) { __builtin_amdgcn_s_sleep(1); \
    if ((++_sp & 255u) == 0u) { if (xb_ld(&(bar)[XB_TMO])) break; if (_sp > XB_SPIN_CAP) { atomicAdd(&(bar)[XB_TMO], 1u); break; } } } } while (0)

struct XcdBarrier {
    unsigned* bar; unsigned x;
    volatile LAS unsigned* st;
};

__device__ __forceinline__ XcdBarrier xcd_barrier_post(unsigned* bar, volatile LAS unsigned* st) {
    XcdBarrier b; b.bar = bar; b.x = xb_xcc_id(); b.st = st;
    if (threadIdx.x == 0) st[2] = xb_add(&bar[XB_XCNT(b.x)], 1u);
    return b;
}
__device__ __forceinline__ void xcd_barrier_complete(unsigned* bar, unsigned x, unsigned& nloc, unsigned& nx, unsigned& even) {
    const unsigned G = gridDim.x * gridDim.y * gridDim.z;
    unsigned sum, cnt, mine, good, sp = 0u;
    for (;;) {
        sum = 0u; cnt = 0u; mine = 0u; good = 0u;
#pragma unroll
        for (unsigned j = 0; j < 16; ++j) { const unsigned c = xb_ld(&bar[XB_XCNT(j)]); sum += c; cnt += (c > 0u) ? 1u : 0u; mine = (j == x) ? c : mine; good += (c == (j < 8u ? 32u : 0u)) ? 1u : 0u; }
        if (sum == G) break;
        __builtin_amdgcn_s_sleep(1);
        if ((++sp & 255u) == 0u) { if (xb_ld(&bar[XB_TMO])) break; if (sp > XB_SPIN_CAP) { atomicAdd(&bar[XB_TMO], 1u); break; } }
    }
    nloc = mine > 0u ? mine : 1u; nx = cnt > 0u ? cnt : 1u;
    even = (sum == G && G == 256u && good == 16u) ? 1u : 2u;
}

__device__ __forceinline__ void xcd_barrier(const XcdBarrier& b) {
    asm volatile("s_waitcnt vmcnt(0)" ::: "memory");
    __syncthreads();
    if (threadIdx.x == 0) {
        unsigned* bar = b.bar;
        __builtin_amdgcn_s_waitcnt(0);
        unsigned nloc = b.st[0], nx = b.st[1];
        if (nloc == 0u) { unsigned even; xcd_barrier_complete(bar, b.x, nloc, nx, even); b.st[0] = nloc; b.st[1] = nx; b.st[3] = even; }
        const unsigned old = xb_add(&bar[XB_XSUB(b.x)], 1u);
        const unsigned gen = old / nloc;
        if (old + 1u == (gen + 1u) * nloc) {
            __builtin_amdgcn_fence(__ATOMIC_RELEASE, "agent");
            asm volatile("s_waitcnt vmcnt(0)" ::: "memory");
            const unsigned og = xb_add(&bar[XB_TOP], 1u);
            const unsigned tg = og / nx;
            if (og + 1u == (tg + 1u) * nx) xb_add(&bar[XB_TOPGEN], 1u);
            else XB_SPIN(xb_ld(&bar[XB_TOPGEN]) == tg, bar);
            __builtin_amdgcn_fence(__ATOMIC_ACQUIRE, "agent");
            xb_add(&bar[XB_XGEN(b.x)], 1u);
            asm volatile("s_waitcnt vmcnt(0)" ::: "memory");
        } else {
            XB_SPIN(xb_ld(&bar[XB_XGEN(b.x)]) == gen, bar);
            __builtin_amdgcn_fence(__ATOMIC_ACQUIRE, "agent");
            asm volatile("s_waitcnt vmcnt(0)" ::: "memory");
        }
    }
    __syncthreads();
}

__device__ __forceinline__ void xcd_local_barrier(const XcdBarrier& b) {
    asm volatile("s_waitcnt vmcnt(0)" ::: "memory");
    __syncthreads();
    if (threadIdx.x == 0) {
        unsigned* bar = b.bar;
        __builtin_amdgcn_s_waitcnt(0);
        const unsigned old = xb_add(&bar[XB_XLOC(b.x)], 1u);
        const unsigned target = (old / 32u + 1u) * 32u;
        XB_SPIN(xb_ld(&bar[XB_XLOC(b.x)]) < target, bar);
        __builtin_amdgcn_fence(__ATOMIC_ACQUIRE, "agent");
        asm volatile("s_waitcnt vmcnt(0)" ::: "memory");
    }
    __syncthreads();
}

struct Args {
    const float *x_prompt, *x_sample, *cache_k, *cache_v, *state_pool, *cache_mem_k, *cache_mem_v, *mem_prompt;
    const float *norm_mix_g, *w_in, *lam_q, *lam_k, *subln_g, *w_pool, *pool_scale, *w_out, *norm_x_g, *norm_mem_g, *wq_x, *wk_x, *wv_x, *wo_x, *norm_mlp_g, *w_up, *w_down, *final_g;
    float* out; unsigned char* ws; int ph_lo, ph_hi;
};
struct Frame { LAS unsigned char* lds; int vcu, G; };
#define AS4 __attribute__((address_space(4)))
typedef const AS4 unsigned char* kargs_t;
#define AF(field) (*(const AS4 decltype(Args::field)*)(kargs + __builtin_offsetof(Args, field)))

__device__ __forceinline__ float wave_sum(float v) { return xsum64(v); }
__device__ __forceinline__ void transpose_item(const float* W, int N, const float* gain, bf16* WT, int Kout, int row_off, LAS float* scr, int item, int lane) {
    const int nblk = N / 32, kb = item / nblk, nb = item % nblk, k0 = 64 * kb, n0 = 32 * nb;
#pragma unroll
    for (int i = 0; i < 32; ++i) { const int kk = 2 * i + (lane >> 5); float v = W[(size_t)(k0 + kk) * N + n0 + (lane & 31)]; if (gain) v *= gain[k0 + kk]; scr[kk * 33 + (lane & 31)] = v; }
    LDS_WAIT(); asm volatile("" ::: "memory");
    const int c = lane & 7;
#pragma unroll
    for (int j = 0; j < 4; ++j) { const int n = (lane >> 3) + 8 * j; const LAS float* s = scr + (8 * c) * 33 + n;
        v4u o; o.x = pk2(s[0 * 33], s[1 * 33]); o.y = pk2(s[2 * 33], s[3 * 33]); o.z = pk2(s[4 * 33], s[5 * 33]); o.w = pk2(s[6 * 33], s[7 * 33]);
        *(GAS v4u*)(WT + (size_t)(row_off + n0 + n) * Kout + k0 + 8 * c) = o; }
    LDS_WAIT(); asm volatile("" ::: "memory");
}
__device__ __forceinline__ void row_to_bf16(const float* xrow, float* copy, bf16* orow, float* ss_slot, int lane) {
    const GAS f32x4* xr = (const GAS f32x4*)xrow + lane;
    f32x4 v[4]; float s = 0.f;
#pragma unroll
    for (int j = 0; j < 4; ++j) { v[j] = xr[64 * j]; s += (v[j].x * v[j].x + v[j].y * v[j].y) + (v[j].z * v[j].z + v[j].w * v[j].w); }
    s = wave_sum(s);
    if (copy) { GAS f32x4* c = (GAS f32x4*)copy + lane;
#pragma unroll
        for (int j = 0; j < 4; ++j) c[64 * j] = v[j]; }
    GAS unsigned long long* o8 = (GAS unsigned long long*)orow + lane;
#pragma unroll
    for (int j = 0; j < 4; ++j) o8[64 * j] = (unsigned long long)pk2(v[j].x, v[j].y) | ((unsigned long long)pk2(v[j].z, v[j].w) << 32);
    if (lane == 0) *ss_slot = s;
}
__device__ __forceinline__ void p0_prologue(kargs_t kargs, Frame& F0) {
    int t_ = threadIdx.x; asm volatile("" : "+v"(t_));
    const int P_tid = t_, P_lane = t_ & 63, P_wave = __builtin_amdgcn_readfirstlane(t_ >> 6), P_vcu = F0.vcu, P_G = F0.G; LAS unsigned char* const P_lds = F0.lds;
    unsigned char* ws = AF(ws);
    LAS float* scr = (LAS float*)(P_lds + P_wave * 16384);
    const int gw = P_vcu * NWAVES + P_wave, NGW = P_G * NWAVES;
    float* ss = (float*)(ws + WS_SS);
    constexpr int I_IN = 16 * 64, I_OUT = 8 * 32, I_SQ = 16 * 32, I_UP = 16 * 128, I_DN = 64 * 32, I_LAYER = I_IN + I_OUT + 4 * I_SQ + I_UP + I_DN;
    for (int it = gw; it < DEPTH * I_LAYER; it += NGW) {
        const int l = it / I_LAYER; int r = it % I_LAYER; bf16* wl = (bf16*)(ws + WS_W + (size_t)l * W_LAYER); bf16* wkv = (bf16*)(ws + WS_W + W_KV);
        if (r < I_IN) { transpose_item(AF(w_in) + (size_t)l * DM * 2048, 2048, AF(norm_mix_g) + l * DM, (bf16*)((unsigned char*)wl + W_IN), DM, 0, scr, r, P_lane); continue; } r -= I_IN;
        if (r < I_OUT) { transpose_item(AF(w_out) + (size_t)l * DM * DM, DM, nullptr, (bf16*)((unsigned char*)wl + W_OUT), DM, 0, scr, r, P_lane); continue; } r -= I_OUT;
        if (r < I_SQ) { transpose_item(AF(wq_x) + (size_t)l * DM * DM, DM, AF(norm_x_g) + l * DM, (bf16*)((unsigned char*)wl + W_Q), DM, 0, scr, r, P_lane); continue; } r -= I_SQ;
        if (r < I_SQ) { transpose_item(AF(wo_x) + (size_t)l * DM * DM, DM, nullptr, (bf16*)((unsigned char*)wl + W_O), DM, 0, scr, r, P_lane); continue; } r -= I_SQ;
        if (r < I_SQ) { transpose_item(AF(wk_x) + (size_t)l * DM * DM, DM, AF(norm_mem_g) + l * DM, wkv, DM, l * 2048, scr, r, P_lane); continue; } r -= I_SQ;
        if (r < I_SQ) { transpose_item(AF(wv_x) + (size_t)l * DM * DM, DM, AF(norm_mem_g) + l * DM, wkv, DM, l * 2048 + 1024, scr, r, P_lane); continue; } r -= I_SQ;
        if (r < I_UP) { transpose_item(AF(w_up) + (size_t)l * DM * DFF, DFF, AF(norm_mlp_g) + l * DM, (bf16*)((unsigned char*)wl + W_UP), DM, 0, scr, r, P_lane); continue; } r -= I_UP;
        transpose_item(AF(w_down) + (size_t)l * DFF * DM, DM, nullptr, (bf16*)((unsigned char*)wl + W_DOWN), DFF, 0, scr, r, P_lane);
    }
    for (int it = gw; it < DEPTH * 4 * 8 * 16; it += NGW) {
        const int nb = it & 15, cb = (it >> 4) & 7, g = (it >> 7) & 3, l = it >> 9; const int n = nb * 64 + P_lane;
        const float* wp = AF(w_pool) + ((size_t)(l * 4 + g) * 128 + cb * 16) * 128; const float* ps = AF(pool_scale) + l * 512 + g * 128; const float* wo = AF(w_out) + (size_t)l * DM * DM + (size_t)(512 + g * 128) * DM + n;
        float acc[16];
#pragma unroll
        for (int c = 0; c < 16; ++c) acc[c] = 0.f;
#pragma unroll 4
        for (int d = 0; d < 128; ++d) { const float w = wo[(size_t)d * DM] * ps[d];
#pragma unroll
            for (int c = 0; c < 16; ++c) acc[c] += wp[c * 128 + d] * w; }
        bf16* wt = (bf16*)(ws + WS_W + (size_t)l * W_LAYER + W_OUT) + (size_t)n * DM + 512 + g * 128 + cb * 16;
        v4u o0, o1; o0.x = pk2(acc[0], acc[1]); o0.y = pk2(acc[2], acc[3]); o0.z = pk2(acc[4], acc[5]); o0.w = pk2(acc[6], acc[7]);
        o1.x = pk2(acc[8], acc[9]); o1.y = pk2(acc[10], acc[11]); o1.z = pk2(acc[12], acc[13]); o1.w = pk2(acc[14], acc[15]);
        *(v4u*)wt = o0; *(v4u*)(wt + 8) = o1;
    }
    for (int m = gw; m < MT; m += NGW) {
        const float* src = m < MP ? AF(x_prompt) + (size_t)m * DM : AF(x_sample) + (size_t)(m - MP) * DM;
        row_to_bf16(src, nullptr, (bf16*)(ws + WS_XB) + (size_t)m * DM, ss + m, P_lane);
    }
    for (int m = gw; m < BATCH * NMEM; m += NGW) row_to_bf16(AF(mem_prompt) + (size_t)m * DM, nullptr, (bf16*)(ws + WS_MEMB) + (size_t)m * DM, ss + 7 * MT + m, P_lane);
    { const size_t n8 = (size_t)DEPTH * DEC_BATCH * NMEM * DM / 8; const size_t gt = (size_t)P_vcu * (NWAVES * 64) + P_tid, NT = (size_t)P_G * NWAVES * 64;
      for (size_t i = gt; i < 2 * n8; i += NT) { const bool isv = i >= n8; const size_t j = isv ? i - n8 : i;
          const float* s = (isv ? AF(cache_mem_v) : AF(cache_mem_k)) + j * 8; const f32x4 a = *(const f32x4*)s, b = *(const f32x4*)(s + 4);
          v4u o; o.x = pk2(a.x, a.y); o.y = pk2(a.z, a.w); o.z = pk2(b.x, b.y); o.w = pk2(b.z, b.w);
          *(v4u*)((bf16*)(ws + (isv ? WS_MVS : WS_MKS)) + j * 8) = o; } }
}
__device__ __forceinline__ void unpack8(const v4u q, float (&f)[8]) { f[0] = bf2f(q.x & 0xffff); f[1] = bf2f(q.x >> 16); f[2] = bf2f(q.y & 0xffff); f[3] = bf2f(q.y >> 16); f[4] = bf2f(q.z & 0xffff); f[5] = bf2f(q.z >> 16); f[6] = bf2f(q.w & 0xffff); f[7] = bf2f(q.w >> 16); }
__device__ __forceinline__ void pool_ext(const bf16* Useq  , const float* hist  , int i, float (&f)[8]) {
    if (i >= 0) { unpack8(*(const v4u*)(Useq + (size_t)i * ZLD), f); }
    else if (hist && i >= -15) { const float* hp = hist + (size_t)(15 + i) * 512; const f32x4 a = *(const f32x4*)hp, b = *(const f32x4*)(hp + 4); f[0] = a.x; f[1] = a.y; f[2] = a.z; f[3] = a.w; f[4] = b.x; f[5] = b.y; f[6] = b.z; f[7] = b.w; }
    else {
#pragma unroll
        for (int e = 0; e < 8; ++e) f[e] = 0.f; }
}
__device__ __forceinline__ void pool_rows(kargs_t kargs, int l, int xx  , int w0  , int lane) {
    asm volatile("" : "+v"(lane));
    const bf16* U = (const bf16*)(AF(ws) + WS_Z) + ZC_U; bf16* mix = (bf16*)(AF(ws) + WS_Z) + ZC_MIX;
    const int c = lane * 8, w = 2 << (lane >> 4);
    constexpr int NBLK_P = MP / 64;
    for (int k = w0; k < 132; k += 128) { const int blk = k < 128 ? xx * 128 + k : NBLK_P + 4 * xx + (k - 128);
        const int row0 = blk * 64; const bool samp = blk >= NBLK_P;
        const int t0 = samp ? 0 : (row0 & (SEQ - 1));
        const bf16* Useq = U + (size_t)(row0 - t0) * ZLD + c;
        const float* hist = samp ? AF(state_pool) + ((size_t)(l * DEC_BATCH + (blk - NBLK_P)) * 15) * 512 + c : nullptr;
        float S[8];
#pragma unroll
        for (int e = 0; e < 8; ++e) S[e] = 0.f;
        for (int j = 1; j < 16; ++j) if (j < w) { float f[8]; pool_ext(Useq, hist, t0 - j, f);
#pragma unroll
            for (int e = 0; e < 8; ++e) S[e] += f[e]; }
        bf16* mrow = mix + (size_t)row0 * ZLD + 512 + c;
#pragma unroll 4
        for (int i = 0; i < 64; ++i) {
            const int t = t0 + i; float cur[8], old[8];
            pool_ext(Useq, hist, t, cur);
#pragma unroll
            for (int e = 0; e < 8; ++e) S[e] += cur[e];
            const int cnt = samp ? w : ((t + 1) < w ? (t + 1) : w); const float ic = 1.0f / (float)cnt;
            v4u o; o.x = pk2(S[0] * ic - cur[0], S[1] * ic - cur[1]); o.y = pk2(S[2] * ic - cur[2], S[3] * ic - cur[3]); o.z = pk2(S[4] * ic - cur[4], S[5] * ic - cur[5]); o.w = pk2(S[6] * ic - cur[6], S[7] * ic - cur[7]);
            *(v4u*)(mrow + (size_t)i * ZLD) = o;
            pool_ext(Useq, hist, t - w + 1, old);
#pragma unroll
            for (int e = 0; e < 8; ++e) S[e] -= old[e];
        }
    }
}

__global__ void __launch_bounds__(NWAVES * 64, 2) fwd_kernel(Args args) {
    extern __shared__ __attribute__((aligned(16))) unsigned char lds_raw[];
    Frame F;
    F.lds = (LAS unsigned char*)lds_raw;
    volatile LAS unsigned* MISC = (volatile LAS unsigned*)(F.lds + MISC_OFF);
    F.G = gridDim.x; { const int bx = blockIdx.x; F.vcu = (F.G % 8 == 0) ? (bx % 8) * (F.G / 8) + bx / 8 : bx; }
    const kargs_t kargs0 = (kargs_t)__builtin_amdgcn_kernarg_segment_ptr();
    gu32* ctl; { const kargs_t kargs = kargs0; ctl = (gu32*)(AF(ws) + WS_CTL); }
    for (int u = threadIdx.x; u < (LDS_BYTES - LDSCTL_OFF) / 4; u += NWAVES * 64) ((LAS unsigned*)(F.lds + LDSCTL_OFF))[u] = 0u;
    __syncthreads();
    XcdBarrier bar; bar.bar = (unsigned*)(ctl + CW_BAR); bar.x = 0; bar.st = nullptr;
    if (!MK_PER_PHASE) bar = xcd_barrier_post((unsigned*)(ctl + CW_BAR), MISC + 8);
    int lo, hi; { const kargs_t kargs = kargs0; lo = AF(ph_lo); hi = AF(ph_hi); } (void)lo; (void)hi;
#if MK_PER_PHASE
#define IN(k) (lo <= (k) && (k) < hi)
#else
#define IN(k) true
#endif
#define SEAM(k) do { if (!MK_PER_PHASE && IN((k) + 1)) { unsigned zb_ = 0u; asm volatile("" : "+s"(zb_)); XcdBarrier b2_; b2_.bar = bar.bar + zb_; b2_.x = bar.x + zb_; b2_.st = bar.st;     \
        xcd_barrier(b2_); } } while (0)
#define SEAM_L(k) do { if (!MK_PER_PHASE) { unsigned zb_ = 0u; asm volatile("" : "+s"(zb_)); XcdBarrier b2_; b2_.bar = bar.bar + zb_; b2_.x = bar.x + zb_; b2_.st = bar.st; \
        if (__builtin_amdgcn_readfirstlane((int)b2_.st[3]) == 1) xcd_local_barrier(b2_); else xcd_barrier(b2_); } } while (0)
#define PHASE_BASES() unsigned z_ = 0u; asm volatile("" : "+s"(z_)); const kargs_t kargs = kargs0 + z_; unsigned char* ws = AF(ws); float* outb = AF(out); const int vcu = F.vcu + (int)z_, bid = (int)blockIdx.x + (int)z_, G = F.G + (int)z_; (void)vcu; (void)bid; (void)G; \
    int tid_p = threadIdx.x; asm volatile("" : "+v"(tid_p)); const int lane_p = tid_p & 63, wave_p = __builtin_amdgcn_readfirstlane(tid_p >> 6); (void)lane_p; (void)wave_p; \
    float* ss = (float*)(ws + WS_SS); bf16* XB = (bf16*)(ws + WS_XB); float* X = outb + O_YP; (void)ss; (void)XB; (void)X

    if (IN(0)) { unsigned z0_ = 0u; asm volatile("" : "+s"(z0_)); p0_prologue(kargs0 + z0_, F); SEAM(0); }
#if !MK_PER_PHASE
    if (__builtin_amdgcn_readfirstlane((int)bar.st[3]) == 1) F.vcu = (int)bar.x * 32 + __builtin_amdgcn_readfirstlane((int)bar.st[2]);
#endif

    for (int l = 0; l < DEPTH; ++l) {
        const int pb = 1 + 8 * l;
        if (IN(pb + 0)) {
            PHASE_BASES(); unsigned char* wl = ws + WS_W + (size_t)l * W_LAYER; (void)wl;
            { pg8::Gemm g{XB, (const bf16*)(wl + W_IN), MP, 2048, DM, DM}; pg8::XcdOrder S; S.init(2048, vcu >> 5, vcu & 31);
              pg8::EpiInProj E{ss + (size_t)(3 * l) * MT, (bf16*)(ws + WS_Z) + ZC_QA, (bf16*)(ws + WS_Z) + ZC_KA, (bf16*)(ws + WS_Z) + ZC_VA, (bf16*)(ws + WS_Z) + ZC_U,
                               outb + O_KP + (size_t)l * MP * 512, outb + O_VP + (size_t)l * MP * 512, outb + O_KS + (size_t)l * MS * 512, outb + O_VS + (size_t)l * MS * 512,
                               outb + O_PP + (size_t)l * BATCH * 15 * 512, outb + O_PS + (size_t)l * DEC_BATCH * 15 * 512, 0.18033688011112042f};
              if (vcu & 1) { pg8::small_gemm<8, 0, 0, 64>(F.lds, XB + (size_t)MP * DM, DM, (const bf16*)(wl + W_IN), DM, MP, vcu, E); }
              pg8::gemm_phase<pg8::EpiInProj, pg8::XcdOrder, true, true>(F.lds, g, S, E);
              if (!(vcu & 1)) { pg8::small_gemm<8, 0, 0, 64>(F.lds, XB + (size_t)MP * DM, DM, (const bf16*)(wl + W_IN), DM, MP, vcu, E); } }
            if (l == 0) {
              pg8::Gemm g{(const bf16*)(ws + WS_MEMB), (const bf16*)(ws + WS_W + W_KV), BATCH * NMEM, 4096, DM, DM}; pg8::OneUnit S{vcu >> 5, vcu & 31, (vcu & 31) < 16};
              pg8::EpiMemKV E{ss + 7 * MT, outb + O_MKP, outb + O_MVP, (bf16*)(ws + WS_MKP), (bf16*)(ws + WS_MVP)};
              pg8::gemm_phase<pg8::EpiMemKV, pg8::OneUnit, true, true>(F.lds, g, S, E); }
            SEAM_L(pb + 0);
        }
        if (IN(pb + 1)) {
            PHASE_BASES(); unsigned char* wl = ws + WS_W + (size_t)l * W_LAYER; (void)wl;
            const float lam_init = l == 0 ? 0.2f : 0.35550906759096926f;
            float lam;
            { const float a = AF(lam_q)[l * 128 + lane_p] * AF(lam_k)[l * 128 + lane_p], b = AF(lam_q)[l * 128 + 64 + lane_p] * AF(lam_k)[l * 128 + 64 + lane_p];
              const float lv = __expf(wave_sum(a)) - __expf(wave_sum(b)) + lam_init;
              lam = __builtin_bit_cast(float, __builtin_amdgcn_readfirstlane(__builtin_bit_cast(int, lv))); }
            const float post = l == 0 ? 0.8f : 0.6444909324090307f;     const float* subg = AF(subln_g) + l * 128;
            const bf16* Qa = (const bf16*)(ws + WS_Z) + ZC_QA; const bf16* Ka = (const bf16*)(ws + WS_Z) + ZC_KA; const bf16* Va = (const bf16*)(ws + WS_Z) + ZC_VA; bf16* mix = (bf16*)(ws + WS_Z) + ZC_MIX;
            if (G == 256) {
                for (int r4 = 0; r4 < 3; ++r4) { const int bh2 = (vcu >> 5) * 4 + r4, j = vcu & 31;
                    att::diff_prompt_unit(F.lds, Qa, Ka, Va, mix, bh2 >> 2, bh2 & 3, 63 - j, lam, post, subg);
                    att::diff_prompt_unit(F.lds, Qa, Ka, Va, mix, bh2 >> 2, bh2 & 3, j, lam, post, subg); }
                att::diff_prompt_unit(F.lds, Qa, Ka, Va, mix, vcu >> 5, 3, 63 - (vcu & 31), lam, post, subg);
                if ((vcu & 31) < 16) att::diff_sample_unit(F.lds, Qa, Ka, Va, AF(cache_k) + (size_t)l * DEC_BATCH * PAST * 512, AF(cache_v) + (size_t)l * DEC_BATCH * PAST * 512, mix, 4 * (vcu >> 5) + ((vcu & 31) >> 2), vcu & 3, lam, post, subg);
                if ((vcu & 31) >= 16) { int t2_ = threadIdx.x; asm volatile("" : "+v"(t2_)); pool_rows(kargs, l, vcu >> 5, ((vcu & 31) - 16) * NWAVES + __builtin_amdgcn_readfirstlane(t2_ >> 6), t2_ & 63); }
                { unsigned* qctr = (unsigned*)(ws + WS_CTL) + CW_TICKET + (l * 8 + (vcu >> 5)) * 64;
                  for (;;) {
                      asm volatile("s_waitcnt vmcnt(0)" ::: "memory"); __syncthreads();
                      if (threadIdx.x == 0) MISC[12] = __hip_atomic_fetch_add(qctr, 1u, __ATOMIC_RELAXED, __HIP_MEMORY_SCOPE_AGENT);
                      __syncthreads();
                      const int q = __builtin_amdgcn_readfirstlane((int)MISC[12]);
                      if (q >= 32) break;
                      att::diff_prompt_unit(F.lds, Qa, Ka, Va, mix, vcu >> 5, 3, 31 - q, lam, post, subg); } }
            }
            SEAM_L(pb + 1);
        }
        if (IN(pb + 2)) {
            PHASE_BASES(); unsigned char* wl = ws + WS_W + (size_t)l * W_LAYER; (void)wl;
            pg8::Gemm g{(const bf16*)(ws + WS_Z) + ZC_MIX, (const bf16*)(wl + W_OUT), MP, DM, DM, ZLD}; pg8::XcdOrder S; S.init(DM, vcu >> 5, vcu & 31);
            pg8::EpiRes E{XB, ss + (size_t)(1 + 3 * l) * MT};
            if (vcu & 1) { pg8::small_gemm<4, 1, 0, 128>(F.lds, (const bf16*)(ws + WS_Z) + ZC_MIX + (size_t)MP * ZLD, ZLD, (const bf16*)(wl + W_OUT), DM, MP, vcu, E); }
            pg8::gemm_phase<pg8::EpiRes, pg8::XcdOrder, true, true>(F.lds, g, S, E);
            if (!(vcu & 1)) { pg8::small_gemm<4, 1, 0, 128>(F.lds, (const bf16*)(ws + WS_Z) + ZC_MIX + (size_t)MP * ZLD, ZLD, (const bf16*)(wl + W_OUT), DM, MP, vcu, E); }
            SEAM_L(pb + 2);
        }
        if (IN(pb + 3)) {
            PHASE_BASES(); unsigned char* wl = ws + WS_W + (size_t)l * W_LAYER; (void)wl;
            pg8::Gemm g{XB, (const bf16*)(wl + W_Q), MP, DM, DM, DM}; pg8::XcdOrder S; S.init(DM, vcu >> 5, vcu & 31);
            pg8::EpiRowScale<0> E{ss + (size_t)(1 + 3 * l) * MT, (bf16*)(ws + WS_Z) + ZC_QX, ZLD, 0.09016844005556021f};
            if (vcu & 1) { pg8::small_gemm<4, 2, 0, 128>(F.lds, XB + (size_t)MP * DM, DM, (const bf16*)(wl + W_Q), DM, MP, vcu, E); }
            pg8::gemm_phase<pg8::EpiRowScale<0>, pg8::XcdOrder, true, true>(F.lds, g, S, E);
            if (!(vcu & 1)) { pg8::small_gemm<4, 2, 0, 128>(F.lds, XB + (size_t)MP * DM, DM, (const bf16*)(wl + W_Q), DM, MP, vcu, E); }
            SEAM_L(pb + 3);
        }
        if (IN(pb + 4)) {
            PHASE_BASES(); unsigned char* wl = ws + WS_W + (size_t)l * W_LAYER; (void)wl;
            const bf16* QX = (const bf16*)(ws + WS_Z) + ZC_QX; bf16* OX = (bf16*)(ws + WS_Z) + ZC_OX;
            const bf16* MKP_ = (const bf16*)(ws + WS_MKP) + (size_t)l * 2048 * DM; const bf16* MVP_ = (const bf16*)(ws + WS_MVP) + (size_t)l * 2048 * DM;
            const bf16* MKS_ = (const bf16*)(ws + WS_MKS) + (size_t)l * DEC_BATCH * NMEM * DM; const bf16* MVS_ = (const bf16*)(ws + WS_MVS) + (size_t)l * DEC_BATCH * NMEM * DM;
            for (int u = vcu * 4; u < 1024; u += G * 4)
                for (int i = 0; i < 4; ++i) { const int tile = (u + i) >> 2, h = (u + i) & 3, b = tile >> 5;
                    att::cross_unit<8>(F.lds, QX + (size_t)tile * 256 * ZLD, MKP_ + (size_t)b * NMEM * DM, MVP_ + (size_t)b * NMEM * DM, OX + (size_t)tile * 256 * ZLD, h); }
            if ((vcu & 31) < 16) { const int b = 4 * (vcu >> 5) + ((vcu & 31) >> 2), h = vcu & 3;
                att::cross_unit<2>(F.lds, QX + (size_t)(MP + b * 64) * ZLD, MKS_ + (size_t)b * NMEM * DM, MVS_ + (size_t)b * NMEM * DM, OX + (size_t)(MP + b * 64) * ZLD, h); }
            SEAM_L(pb + 4);
        }
        if (IN(pb + 5)) {
            PHASE_BASES(); unsigned char* wl = ws + WS_W + (size_t)l * W_LAYER; (void)wl;
            pg8::Gemm g{(const bf16*)(ws + WS_Z) + ZC_OX, (const bf16*)(wl + W_O), MP, DM, DM, ZLD}; pg8::XcdOrder S; S.init(DM, vcu >> 5, vcu & 31);
            pg8::EpiRes E{XB, ss + (size_t)(2 + 3 * l) * MT};
            if (vcu & 1) { pg8::small_gemm<4, 1, 0, 128>(F.lds, (const bf16*)(ws + WS_Z) + ZC_OX + (size_t)MP * ZLD, ZLD, (const bf16*)(wl + W_O), DM, MP, vcu, E); }
            pg8::gemm_phase<pg8::EpiRes, pg8::XcdOrder, true, true>(F.lds, g, S, E);
            if (!(vcu & 1)) { pg8::small_gemm<4, 1, 0, 128>(F.lds, (const bf16*)(ws + WS_Z) + ZC_OX + (size_t)MP * ZLD, ZLD, (const bf16*)(wl + W_O), DM, MP, vcu, E); }
            SEAM_L(pb + 5);
        }
        if (IN(pb + 6)) {
            PHASE_BASES(); unsigned char* wl = ws + WS_W + (size_t)l * W_LAYER; (void)wl;
            pg8::Gemm g{XB, (const bf16*)(wl + W_UP), MP, DFF, DM, DM}; pg8::XcdOrder S; S.init(DFF, vcu >> 5, vcu & 31);
            pg8::EpiRowScale<1> E{ss + (size_t)(2 + 3 * l) * MT, (bf16*)(ws + WS_Z), DFF, 1.0f};
            if (vcu & 1) { pg8::small_gemm<16, 2, 1, 64>(F.lds, XB + (size_t)MP * DM, DM, (const bf16*)(wl + W_UP), DM, MP, vcu, E); }
            pg8::gemm_phase<pg8::EpiRowScale<1>, pg8::XcdOrder, true, true>(F.lds, g, S, E);
            if (!(vcu & 1)) { pg8::small_gemm<16, 2, 1, 64>(F.lds, XB + (size_t)MP * DM, DM, (const bf16*)(wl + W_UP), DM, MP, vcu, E); }
            SEAM_L(pb + 6);
        }
        if (IN(pb + 7)) {
            PHASE_BASES(); unsigned char* wl = ws + WS_W + (size_t)l * W_LAYER; (void)wl;
            pg8::Gemm g{(const bf16*)(ws + WS_Z), (const bf16*)(wl + W_DOWN), MP, DM, DFF, DFF}; pg8::XcdOrder S; S.init(DM, vcu >> 5, vcu & 31);
            pg8::EpiRes E{XB, ss + (size_t)(3 + 3 * l) * MT};
            if (vcu & 1) { pg8::small_gemm<4, 1, 0, 128>(F.lds, (const bf16*)(ws + WS_Z) + (size_t)MP * DFF, DFF, (const bf16*)(wl + W_DOWN), DFF, MP, vcu, E); }
            pg8::gemm_phase<pg8::EpiRes, pg8::XcdOrder, true, true>(F.lds, g, S, E);
            if (!(vcu & 1)) { pg8::small_gemm<4, 1, 0, 128>(F.lds, (const bf16*)(ws + WS_Z) + (size_t)MP * DFF, DFF, (const bf16*)(wl + W_DOWN), DFF, MP, vcu, E); }
            SEAM_L(pb + 7);
        }
    }
    if (IN(17)) {
        PHASE_BASES();
        const int ln = lane_p;
        const float* sq = ss + (size_t)6 * MT; const GAS f32x4* gp = (const GAS f32x4*)AF(final_g) + ln;
        const f32x4 g0 = gp[0], g1 = gp[64], g2 = gp[128], g3 = gp[192];
        for (int k = (vcu & 31) * NWAVES + wave_p; k < 8448; k += 32 * NWAVES) { const int m = k < 8192 ? (vcu >> 5) * 8192 + k : MP + (vcu >> 5) * 256 + (k - 8192);
            const float rs = 1.0f / sqrtf(sq[m] * (1.0f / 1024.0f) + 1e-6f);
            const GAS unsigned long long* xr = (const GAS unsigned long long*)(XB + (size_t)m * DM) + ln;
            GAS f32x4* yr = (GAS f32x4*)(X + (size_t)m * DM) + ln;
            const unsigned long long q0 = xr[0], q1 = xr[64], q2 = xr[128], q3 = xr[192];
#define UNP4(q) (f32x4){__builtin_bit_cast(float, (unsigned)(q) << 16), __builtin_bit_cast(float, (unsigned)(q) & 0xffff0000u), __builtin_bit_cast(float, (unsigned)((q) >> 32) << 16), __builtin_bit_cast(float, (unsigned)((q) >> 32) & 0xffff0000u)}
            yr[0] = UNP4(q0) * rs * g0; yr[64] = UNP4(q1) * rs * g1; yr[128] = UNP4(q2) * rs * g2; yr[192] = UNP4(q3) * rs * g3;
#undef UNP4
        }
    }
#undef IN
#undef SEAM
}

extern "C" void kernel_launch(void* const* d_in, const int* in_sizes, int n_in, void* d_out, int out_size, void* d_ws, size_t ws_size, hipStream_t stream) {
    static int grid = 0;
    if (grid == 0) {
        if (n_in != 26 || in_sizes[0] != MP * DM || (size_t)out_size != O_END || ws_size < WS_END) {
            fprintf(stderr, "kernel_launch: shape mismatch: n_in %d in0 %d out %d (want %zu) ws %zu (need %zu); nothing launched\n", n_in, n_in > 0 ? in_sizes[0] : -1, out_size, (size_t)O_END, ws_size, (size_t)WS_END); grid = -1; return; }
        int dev = 0, cus = 0, per_cu = 0;
        if (hipGetDevice(&dev) != hipSuccess || hipDeviceGetAttribute(&cus, hipDeviceAttributeMultiprocessorCount, dev) != hipSuccess) { fprintf(stderr, "kernel_launch: device query failed\n"); grid = -1; return; }
        if (hipFuncSetAttribute((const void*)fwd_kernel, hipFuncAttributeMaxDynamicSharedMemorySize, LDS_BYTES) != hipSuccess) { fprintf(stderr, "kernel_launch: hipFuncSetAttribute failed\n"); grid = -1; return; }
        if (hipOccupancyMaxActiveBlocksPerMultiprocessor(&per_cu, (const void*)fwd_kernel, NWAVES * 64, LDS_BYTES) != hipSuccess || per_cu < 1)
            fprintf(stderr, "kernel_launch: note: occupancy query reports %d workgroups per CU\n", per_cu);
        (void)hipGetLastError();
        if (cus != 256) { fprintf(stderr, "kernel_launch: built for a 256-CU device (the attention phase deals its units over exactly 256 workgroups), found %d CUs; nothing launched\n", cus); grid = -1; return; }
        grid = cus;
    }
    if (grid < 0) return;
    if (hipMemsetAsync((char*)d_ws + WS_CTL, 0, CTL_ZERO_BYTES, stream) != hipSuccess) { fprintf(stderr, "kernel_launch: memset failed\n"); return; }
    Args a{};
    const float** ap = (const float**)&a;
    for (int i = 0; i < 26; ++i) ap[i] = (const float*)d_in[i];
    a.out = (float*)d_out; a.ws = (unsigned char*)d_ws;
#if MK_PER_PHASE
    for (int p = 0; p < NPH; ++p) { a.ph_lo = p; a.ph_hi = p + 1; hipLaunchKernelGGL(fwd_kernel, dim3(grid), dim3(NWAVES * 64), LDS_BYTES, stream, a); }
#else
    a.ph_lo = 0; a.ph_hi = NPH; hipLaunchKernelGGL(fwd_kernel, dim3(grid), dim3(NWAVES * 64), LDS_BYTES, stream, a);
#endif
    const hipError_t le = hipPeekAtLastError();
    if (le != hipSuccess) fprintf(stderr, "kernel_launch: launch failed: %s\n", hipGetErrorName(le));
}
```

```cpp
#include <hip/hip_runtime.h>
#include <hip/hip_bf16.h>
#include <cstdio>
#include <cstdint>
constexpr int ZLD = 4096;

#ifndef USE_SHFL
#define USE_SHFL 0
#endif
#if USE_SHFL
template <int K> __device__ __forceinline__ float swz_xor(float v) { return __shfl_xor(v, K); }
#else
template <int K> __device__ __forceinline__ float swz_xor(float v) { return __builtin_bit_cast(float, __builtin_amdgcn_ds_swizzle(__builtin_bit_cast(int, v), (K << 10) | 0x1f)); }
#endif
__device__ __forceinline__ float xsum32(float v) { v += swz_xor<1>(v); v += swz_xor<2>(v); v += swz_xor<4>(v); v += swz_xor<8>(v); v += swz_xor<16>(v); return v; }
__device__ __forceinline__ float xsum64(float v) { v = xsum32(v); return __builtin_bit_cast(float, __builtin_amdgcn_readlane(__builtin_bit_cast(int, v), 0)) + __builtin_bit_cast(float, __builtin_amdgcn_readlane(__builtin_bit_cast(int, v), 32)); }
namespace pg8 {
#define PG8_LAS __attribute__((address_space(3)))
typedef unsigned short bf16_t;
typedef short bf16x8 __attribute__((ext_vector_type(8)));
typedef float f32x4 __attribute__((ext_vector_type(4)));
typedef unsigned u32x4 __attribute__((ext_vector_type(4)));
constexpr int BM = 256, BK = 64, HALF = 128, HTB = HALF * BK * 2  , STAGE_BYTES = 8 * HTB, NXCD = 8, WGM = 8;

__host__ __device__ __forceinline__ int lds_byte(int r, int c) { const int st = (r >> 4) * 2 + (c >> 5), rr = r & 15, cc = c & 31, ob = rr * 64 + cc * 2; return st * 1024 + (ob ^ (((ob >> 9) & 1) << 5)); }
__host__ __device__ __forceinline__ void stage_rc(int b, int& R, int& C) { const int st = b / 1024, sb = b % 1024, swz = sb ^ (((sb >> 9) & 1) << 5); R = (st >> 1) * 16 + swz / 64; C = (st & 1) * 32 + (swz % 64) / 2; }
__host__ __device__ __forceinline__ int perm32(int rho) { const int n = rho >> 4, i = rho & 15; return 8 * (i >> 2) + 4 * n + (i & 3); }

struct Unit { int pm, pn; };
struct Gemm { const bf16_t* A; const bf16_t* Bt; int M, N, K, lda; };

struct StaticOrder {
    int nM, nN, nwg, G, c;
    __host__ __device__ void init(int M, int N, int G_, int c_) { nM = M / BM; nN = N / BM; nwg = nM * nN; G = G_; c = c_; }
    __host__ __device__ bool next(int i, Unit& u) const {
        const long L = (long)i * G + c; if (L >= nwg) return false;
        int wgid = (int)L; { const int q = nwg / NXCD, r = nwg % NXCD, xcd = wgid % NXCD, off = wgid / NXCD; wgid = (xcd < r ? xcd * (q + 1) : r * (q + 1) + (xcd - r) * q) + off; }
        const int nig = WGM * nN, gid = wgid / nig, fm = gid * WGM, gsz = (nM - fm) < WGM ? (nM - fm) : WGM;
        u.pm = fm + ((wgid % nig) % gsz); u.pn = (wgid % nig) / gsz; return true;
    }
    __device__ __forceinline__ void a_ready(const Unit&) const {}
    __device__ __forceinline__ void done(const Unit&) const {}
};

struct XcdOrder {
    int nN, x, j;
    __host__ __device__ void init(int N, int x_, int j_) { nN = N / BM; x = x_; j = j_; }
    __host__ __device__ bool next(int i, Unit& u) const {
        const int wl = i * 32 + j; if (wl >= 32 * nN) return false;
        const int nig = WGM * nN, gid = wl / nig, r = wl % nig;
        u.pm = 32 * x + gid * WGM + (r % WGM); u.pn = r / WGM; return true;
    }
    __device__ __forceinline__ void a_ready(const Unit&) const {}
    __device__ __forceinline__ void done(const Unit&) const {}
};

struct OneUnit {
    int pm, pn; bool on;
    __host__ __device__ bool next(int i, Unit& u) const { if (i != 0 || !on) return false; u.pm = pm; u.pn = pn; return true; }
    __device__ __forceinline__ void a_ready(const Unit&) const {}
    __device__ __forceinline__ void done(const Unit&) const {}
};

__device__ __forceinline__ unsigned cvt_pk_bf16(float lo, float hi) { unsigned r; asm volatile("v_cvt_pk_bf16_f32 %0, %1, %2" : "=v"(r) : "v"(lo), "v"(hi)); return r; }
typedef float f32x2 __attribute__((ext_vector_type(2)));
constexpr int NROWS_P = 65536;
constexpr float NORM_EPS_F = 1e-6f;
__device__ __forceinline__ float row_rstd(const float* ss, int row) { return 1.0f / sqrtf(ss[row] * (1.0f / 1024.0f) + NORM_EPS_F); }
__device__ __forceinline__ u32x4 pack8(f32x4 v0, f32x4 v1) { u32x4 w; w.x = cvt_pk_bf16(v0[0], v0[1]); w.y = cvt_pk_bf16(v0[2], v0[3]); w.z = cvt_pk_bf16(v1[0], v1[1]); w.w = cvt_pk_bf16(v1[2], v1[3]); return w; }

struct EpiInProj {
    static constexpr bool PERM = true, AFTER_DRAIN = false;
    const float* ss; bf16_t *Qa, *Ka, *Va, *U; float *kout_p, *vout_p, *kout_s, *vout_s, *pool_p, *pool_s; float qscale;
    __device__ __forceinline__ void operator()(const f32x4 (&acc)[2][2][4][2], const Unit& u, int wr, int wc, int fr_, int fq_) const {
        int fr = fr_, fq = fq_; asm volatile("" : "+v"(fr), "+v"(fq));
        const int sect = u.pn >> 1, half = u.pn & 1; const bool samp = u.pm >= (NROWS_P / BM);
#pragma unroll
        for (int ai = 0; ai < 2; ++ai)
#pragma unroll
            for (int m = 0; m < 4; ++m) {
                const int row = u.pm * BM + ai * HALF + wr * 64 + m * 16 + fr;
                float rs = row_rstd(ss, row); if (sect == 0) rs *= qscale;
                const int srow = row - NROWS_P;
#pragma unroll
                for (int bj = 0; bj < 2; ++bj) {
                    const int c = bj * HALF + wc * 32 + 8 * fq;
                    const f32x4 v0 = acc[ai][bj][m][0] * rs, v1 = acc[ai][bj][m][1] * rs;
                    const u32x4 w = pack8(v0, v1);
                    if (sect == 0) { *(u32x4*)(Qa + (size_t)row * ZLD + (c >> 6) * 128 + half * 64 + (c & 63)) = w; }
                    else if (sect == 1) { *(u32x4*)(Ka + (size_t)row * ZLD + (c >> 6) * 128 + half * 64 + (c & 63)) = w;
                        float* o = (samp ? kout_s + (size_t)srow * 512 : kout_p + (size_t)row * 512) + half * 256 + c; *(f32x4*)o = v0; *(f32x4*)(o + 4) = v1; }
                    else if (sect == 2) { *(u32x4*)(Va + (size_t)row * ZLD + half * 256 + c) = w;
                        float* o = (samp ? vout_s + (size_t)srow * 512 : vout_p + (size_t)row * 512) + half * 256 + c; *(f32x4*)o = v0; *(f32x4*)(o + 4) = v1; }
                    else { *(u32x4*)(U + (size_t)row * ZLD + half * 256 + c) = w;
                        if (!samp) { const int t = row & 8191, b = row >> 13; if (t >= 8192 - 15) { float* o = pool_p + ((size_t)(b * 15 + t - (8192 - 15))) * 512 + half * 256 + c; *(f32x4*)o = v0; *(f32x4*)(o + 4) = v1; } }
                        else { const int t = srow & 63, b = srow >> 6; if (t >= 64 - 15) { float* o = pool_s + ((size_t)(b * 15 + t - (64 - 15))) * 512 + half * 256 + c; *(f32x4*)o = v0; *(f32x4*)(o + 4) = v1; } } }
                }
            }
    }
};
__device__ __forceinline__ void inproj_small(const EpiInProj& E, int row, int col, f32x4 v) {
    typedef unsigned u32x2_t __attribute__((ext_vector_type(2)));
    const int sect = col >> 9, half = (col >> 8) & 1, c = col & 255, srow = row - NROWS_P;
    float rs = row_rstd(E.ss, row); if (sect == 0) rs *= E.qscale;
    v = v * rs;
    u32x2_t w; w.x = cvt_pk_bf16(v[0], v[1]); w.y = cvt_pk_bf16(v[2], v[3]);
    if (sect == 0) { *(u32x2_t*)(E.Qa + (size_t)row * ZLD + (c >> 6) * 128 + half * 64 + (c & 63)) = w; }
    else if (sect == 1) { *(u32x2_t*)(E.Ka + (size_t)row * ZLD + (c >> 6) * 128 + half * 64 + (c & 63)) = w; *(f32x4*)(E.kout_s + (size_t)srow * 512 + half * 256 + c) = v; }
    else if (sect == 2) { *(u32x2_t*)(E.Va + (size_t)row * ZLD + half * 256 + c) = w; *(f32x4*)(E.vout_s + (size_t)srow * 512 + half * 256 + c) = v; }
    else { *(u32x2_t*)(E.U + (size_t)row * ZLD + half * 256 + c) = w;
        const int t = srow & 63, b = srow >> 6; if (t >= 64 - 15) *(f32x4*)(E.pool_s + ((size_t)(b * 15 + t - (64 - 15))) * 512 + half * 256 + c) = v; }
}
__device__ __forceinline__ float bf_lo(unsigned w) { return __builtin_bit_cast(float, w << 16); }
__device__ __forceinline__ float bf_hi(unsigned w) { return __builtin_bit_cast(float, w & 0xffff0000u); }
struct EpiRes {
    static constexpr bool PERM = true, AFTER_DRAIN = false;
    bf16_t* xb; float* ss_next;
    __device__ __forceinline__ void operator()(const f32x4 (&acc)[2][2][4][2], const Unit& u, int wr, int wc, int fr_, int fq_) const {
        int fr = fr_, fq = fq_; asm volatile("" : "+v"(fr), "+v"(fq));
#pragma unroll
        for (int ai = 0; ai < 2; ++ai) {
            float tot = 0.f;
#pragma unroll
            for (int m = 0; m < 4; ++m) {
                const int row = u.pm * BM + ai * HALF + wr * 64 + m * 16 + fr; float s = 0.f;
#pragma unroll
                for (int bj = 0; bj < 2; ++bj) {
                    const size_t off = (size_t)row * 1024 + u.pn * BM + bj * HALF + wc * 32 + 8 * fq;
                    const u32x4 xo = *(const u32x4*)(xb + off);
                    f32x4 x0 = {bf_lo(xo.x), bf_hi(xo.x), bf_lo(xo.y), bf_hi(xo.y)}, x1 = {bf_lo(xo.z), bf_hi(xo.z), bf_lo(xo.w), bf_hi(xo.w)};
                    x0 += acc[ai][bj][m][0]; x1 += acc[ai][bj][m][1];
                    const u32x4 xn = pack8(x0, x1);
                    *(u32x4*)(xb + off) = xn;
                    const float r0 = bf_lo(xn.x), r1 = bf_hi(xn.x), r2 = bf_lo(xn.y), r3 = bf_hi(xn.y), r4 = bf_lo(xn.z), r5 = bf_hi(xn.z), r6 = bf_lo(xn.w), r7 = bf_hi(xn.w);
                    s += (r0 * r0 + r1 * r1) + (r2 * r2 + r3 * r3) + (r4 * r4 + r5 * r5) + (r6 * r6 + r7 * r7);
                }
                s += swz_xor<16>(s);
                float sa = s, sb = s;
                asm volatile("s_nop 1\n\tv_permlane32_swap_b32 %0, %1\n\ts_nop 1" : "+v"(sa), "+v"(sb));
                const float t = sa + sb;
                tot = (fq == m) ? t : tot;
            }
            atomicAdd(ss_next + (u.pm * BM + ai * HALF + wr * 64) + fq * 16 + fr, tot);
        }
    }
};
template <int ACT> struct EpiRowScale {
    static constexpr bool PERM = true, AFTER_DRAIN = false;
    const float* ss; bf16_t* O; int ldc; float scale;
    __device__ __forceinline__ void operator()(const f32x4 (&acc)[2][2][4][2], const Unit& u, int wr, int wc, int fr_, int fq_) const {
        int fr = fr_, fq = fq_; asm volatile("" : "+v"(fr), "+v"(fq));
#pragma unroll
        for (int ai = 0; ai < 2; ++ai)
#pragma unroll
            for (int m = 0; m < 4; ++m) {
                const int row = u.pm * BM + ai * HALF + wr * 64 + m * 16 + fr; const float rs = row_rstd(ss, row) * scale;
#pragma unroll
                for (int bj = 0; bj < 2; ++bj) {
                    f32x4 v0 = acc[ai][bj][m][0] * rs, v1 = acc[ai][bj][m][1] * rs;
                    if (ACT == 1) {
#pragma unroll
                        for (int e = 0; e < 4; ++e) { const float a = fmaxf(v0[e], 0.f), b = fmaxf(v1[e], 0.f); v0[e] = a * a; v1[e] = b * b; } }
                    __builtin_nontemporal_store(pack8(v0, v1), (u32x4*)(O + (size_t)row * ldc + u.pn * BM + bj * HALF + wc * 32 + 8 * fq));
                }
            }
    }
};
struct EpiMemKV {
    static constexpr bool PERM = true, AFTER_DRAIN = false;
    const float* ss; float *kout, *vout; bf16_t *kb, *vb;
    __device__ __forceinline__ void operator()(const f32x4 (&acc)[2][2][4][2], const Unit& u, int wr, int wc, int fr_, int fq_) const {
        int fr = fr_, fq = fq_; asm volatile("" : "+v"(fr), "+v"(fq));
        const int sel = u.pn >> 2, layer = sel >> 1; const bool isv = sel & 1;
        float* of = (isv ? vout : kout) + (size_t)layer * 2048 * 1024; bf16_t* ob = (isv ? vb : kb) + (size_t)layer * 2048 * 1024;
#pragma unroll
        for (int ai = 0; ai < 2; ++ai)
#pragma unroll
            for (int m = 0; m < 4; ++m) {
                const int row = u.pm * BM + ai * HALF + wr * 64 + m * 16 + fr; const float rs = row_rstd(ss, row);
#pragma unroll
                for (int bj = 0; bj < 2; ++bj) {
                    const size_t off = (size_t)row * 1024 + (u.pn & 3) * BM + bj * HALF + wc * 32 + 8 * fq;
                    const f32x4 v0 = acc[ai][bj][m][0] * rs, v1 = acc[ai][bj][m][1] * rs;
                    *(f32x4*)(of + off) = v0; *(f32x4*)(of + off + 4) = v1; *(u32x4*)(ob + off) = pack8(v0, v1);
                }
            }
    }
};
template <class Epi, class Sched, bool ALIGN_EPI = false, bool SP2 = false>
__device__ __forceinline__ void gemm_phase(PG8_LAS unsigned char* lds, const Gemm g, const Sched& S, const Epi& E) {
    int tid_ = threadIdx.x; asm volatile("" : "+v"(tid_));
    const int tid = tid_, wid = __builtin_amdgcn_readfirstlane(tid >> 6), lane = tid & 63, wr = wid >> 2, wc = wid & 3, fr = lane & 15, fq = lane >> 4;
    const int K = g.K, nt = K / BK;
    unsigned voffA[2], voffB[2];
#pragma unroll
    for (int i = 0; i < 2; ++i) { int R, C; stage_rc(tid * 16 + i * 8192, R, C); const int Rb = Epi::PERM ? ((R & ~31) + perm32(R & 31)) : R;
        voffA[i] = (unsigned)(R * g.lda + C) * 2u; voffB[i] = (unsigned)(Rb * K + C) * 2u; }
    const size_t kstep = (size_t)(BK * 2);
    const size_t hstepB = (size_t)HALF * K * 2, hstepA = (size_t)HALF * g.lda * 2;
    const size_t tstepB = 2 * hstepB, tstepA = 2 * hstepA;
    const unsigned ldsw = (unsigned)wid * 1024u;
    const int aoff = lds_byte(wr * 64 + fr, fq * 8), boff = lds_byte(wc * 32 + fr, fq * 8);
#define PG8_SA(b, h) (((b) * 2 + (h)) * HTB)
#define PG8_SB(b, h) ((4 + (b) * 2 + (h)) * HTB)
#define PG8_STAGE(bufoff, gbase, voff) do { _Pragma("unroll") for (int _i = 0; _i < 2; ++_i) \
        __builtin_amdgcn_global_load_lds((const unsigned*)((const char*)(gbase) + (voff)[_i]), (PG8_LAS unsigned*)(lds + (bufoff) + ldsw + _i * 8192), 16, 0, 0); } while (0)
#define PG8_LDA(dst, b, h) do { _Pragma("unroll") for (int m = 0; m < 4; ++m) _Pragma("unroll") for (int k = 0; k < 2; ++k) dst[m][k] = *(const PG8_LAS bf16x8*)(lds + PG8_SA(b, h) + aoff + m * 2048 + k * 1024); } while (0)
#define PG8_LDB(dst, b, h) do { _Pragma("unroll") for (int n = 0; n < 2; ++n) _Pragma("unroll") for (int k = 0; k < 2; ++k) dst[n][k] = *(const PG8_LAS bf16x8*)(lds + PG8_SB(b, h) + boff + n * 2048 + k * 1024); } while (0)
#define PG8_MMA(ai, bj, At, Bt) do { __builtin_amdgcn_s_setprio(1); _Pragma("unroll") for (int m = 0; m < 4; ++m) _Pragma("unroll") for (int n = 0; n < 2; ++n) _Pragma("unroll") for (int k = 0; k < 2; ++k) \
        acc[ai][bj][m][n] = __builtin_amdgcn_mfma_f32_16x16x32_bf16(Bt[n][k], At[m][k], acc[ai][bj][m][n], 0, 0, 0); __builtin_amdgcn_s_setprio(0); } while (0)
#define PG8_WAIT_V(n) asm volatile("s_waitcnt vmcnt(" #n ")" ::: "memory")
#define PG8_WAIT_L(n) asm volatile("s_waitcnt lgkmcnt(" #n ")" ::: "memory")
#define PG8_BAR __builtin_amdgcn_s_barrier()
#define PG8_SCHED __builtin_amdgcn_sched_barrier(0)
    Unit cur, nxt; int ui = 0;
    if (!S.next(0, cur)) return;
    f32x4 acc[2][2][4][2];
#pragma unroll
    for (int a = 0; a < 2; ++a)
#pragma unroll
        for (int b = 0; b < 2; ++b)
#pragma unroll
            for (int m = 0; m < 4; ++m)
#pragma unroll
                for (int n = 0; n < 2; ++n) acc[a][b][m][n] = (f32x4){0.f, 0.f, 0.f, 0.f};
    bf16x8 At[4][2], B0[2][2], B1[2][2];
    const char* cA = (const char*)g.A + (size_t)cur.pm * tstepA; const char* cB = (const char*)g.Bt + (size_t)cur.pn * tstepB;
    S.a_ready(cur);
    if constexpr (SP2) {
        PG8_STAGE(PG8_SB(0, 0), cB, voffB); PG8_STAGE(PG8_SB(0, 1), cB + hstepB, voffB); PG8_STAGE(PG8_SA(0, 0), cA, voffA); PG8_STAGE(PG8_SA(0, 1), cA + hstepA, voffA);
        if (wr == 1) PG8_BAR;
        PG8_WAIT_V(2); PG8_BAR;
        PG8_STAGE(PG8_SB(1, 0), cB + kstep, voffB); PG8_STAGE(PG8_SA(1, 0), cA + kstep, voffA); PG8_STAGE(PG8_SB(1, 1), cB + hstepB + kstep, voffB);
        PG8_WAIT_V(6); PG8_BAR;
    } else {
        PG8_STAGE(PG8_SB(0, 0), cB, voffB); PG8_STAGE(PG8_SA(0, 0), cA, voffA); PG8_STAGE(PG8_SB(0, 1), cB + hstepB, voffB); PG8_STAGE(PG8_SA(0, 1), cA + hstepA, voffA);
        if (wr == 1) PG8_BAR;
        PG8_WAIT_V(4); PG8_BAR;
        PG8_STAGE(PG8_SB(1, 0), cB + kstep, voffB); PG8_STAGE(PG8_SA(1, 0), cA + kstep, voffA); PG8_STAGE(PG8_SB(1, 1), cB + hstepB + kstep, voffB);
        PG8_WAIT_V(6); PG8_BAR;
    }
    for (;;) {
        const bool has_next = S.next(ui + 1, nxt);
        const char* nA = has_next ? (const char*)g.A + (size_t)nxt.pm * tstepA : cA; const char* nB = has_next ? (const char*)g.Bt + (size_t)nxt.pn * tstepB : cB;
        for (int t = 0; t < nt; t += 2) {
            const bool last = (t == nt - 2);
            const char* a1 = cA + (size_t)(t + 1) * kstep;
            const char* a2 = last ? nA : cA + (size_t)(t + 2) * kstep; const char* b2 = last ? nB : cB + (size_t)(t + 2) * kstep;
            const char* a3 = a2 + kstep; const char* b3 = b2 + kstep;
            if (last && has_next) S.a_ready(nxt);
            if constexpr (SP2) {
            PG8_LDB(B0, 0, 0); PG8_LDB(B1, 0, 1); PG8_SCHED; PG8_LDA(At, 0, 0); PG8_STAGE(PG8_SA(1, 1), a1 + hstepA, voffA);
            PG8_WAIT_V(8); PG8_WAIT_L(0); PG8_BAR; PG8_MMA(0, 0, At, B0); PG8_MMA(0, 1, At, B1); PG8_BAR; PG8_SCHED;
            PG8_LDA(At, 0, 1); PG8_STAGE(PG8_SB(0, 0), b2, voffB); PG8_STAGE(PG8_SB(0, 1), b2 + hstepB, voffB); PG8_STAGE(PG8_SA(0, 0), a2, voffA);
            PG8_WAIT_V(8); PG8_WAIT_L(0); PG8_BAR; PG8_MMA(1, 0, At, B0); PG8_MMA(1, 1, At, B1); PG8_BAR; PG8_SCHED;
            PG8_LDB(B0, 1, 0); PG8_LDB(B1, 1, 1); PG8_SCHED; PG8_LDA(At, 1, 0); PG8_STAGE(PG8_SA(0, 1), a2 + hstepA, voffA);
            PG8_WAIT_V(8); PG8_WAIT_L(0); PG8_BAR; PG8_MMA(0, 0, At, B0); PG8_MMA(0, 1, At, B1); PG8_BAR; PG8_SCHED;
            PG8_LDA(At, 1, 1); PG8_STAGE(PG8_SB(1, 0), b3, voffB); PG8_STAGE(PG8_SB(1, 1), b3 + hstepB, voffB); PG8_STAGE(PG8_SA(1, 0), a3, voffA);
            PG8_WAIT_V(8); PG8_WAIT_L(0); PG8_BAR; PG8_MMA(1, 0, At, B0); PG8_MMA(1, 1, At, B1); PG8_BAR; PG8_SCHED;
            } else {
            PG8_LDB(B0, 0, 0); PG8_SCHED; PG8_LDA(At, 0, 0); PG8_STAGE(PG8_SA(1, 1), a1 + hstepA, voffA);
            PG8_WAIT_L(8); PG8_BAR; PG8_WAIT_L(0); PG8_MMA(0, 0, At, B0); PG8_BAR; PG8_SCHED;
            PG8_LDB(B1, 0, 1); PG8_STAGE(PG8_SB(0, 0), b2, voffB);
            PG8_BAR; PG8_WAIT_L(0); PG8_MMA(0, 1, At, B1); PG8_BAR;
            PG8_LDA(At, 0, 1); PG8_STAGE(PG8_SA(0, 0), a2, voffA);
            PG8_BAR; PG8_WAIT_L(0); PG8_MMA(1, 0, At, B0); PG8_BAR; PG8_SCHED;
            PG8_STAGE(PG8_SB(0, 1), b2 + hstepB, voffB);
            PG8_WAIT_V(6); PG8_BAR; PG8_MMA(1, 1, At, B1); PG8_BAR;
            PG8_LDB(B0, 1, 0); PG8_SCHED; PG8_LDA(At, 1, 0); PG8_STAGE(PG8_SA(0, 1), a2 + hstepA, voffA);
            PG8_WAIT_L(8); PG8_BAR; PG8_WAIT_L(0); PG8_MMA(0, 0, At, B0); PG8_BAR; PG8_SCHED;
            PG8_LDB(B1, 1, 1); PG8_STAGE(PG8_SB(1, 0), b3, voffB);
            PG8_BAR; PG8_WAIT_L(0); PG8_MMA(0, 1, At, B1); PG8_BAR;
            PG8_LDA(At, 1, 1); PG8_STAGE(PG8_SA(1, 0), a3, voffA);
            PG8_BAR; PG8_WAIT_L(0); PG8_MMA(1, 0, At, B0); PG8_BAR; PG8_SCHED;
            PG8_STAGE(PG8_SB(1, 1), b3 + hstepB, voffB);
            PG8_WAIT_V(6); PG8_BAR; PG8_MMA(1, 1, At, B1); PG8_BAR;
            }
        }
        if constexpr (ALIGN_EPI) { if (wr == 0) PG8_BAR; }
        if constexpr (!Epi::AFTER_DRAIN) { E(acc, cur, wr, wc, fr, fq); S.done(cur); }
        if (!has_next) break;
#pragma unroll
        for (int a = 0; a < 2; ++a)
#pragma unroll
            for (int b = 0; b < 2; ++b)
#pragma unroll
                for (int m = 0; m < 4; ++m)
#pragma unroll
                    for (int n = 0; n < 2; ++n) acc[a][b][m][n] = (f32x4){0.f, 0.f, 0.f, 0.f};
        cur = nxt; cA = nA; cB = nB; ++ui;
        if constexpr (ALIGN_EPI) { if (wr == 1) PG8_BAR; }
    }
    PG8_WAIT_V(0);
    if constexpr (!ALIGN_EPI) { if (wr == 0) PG8_BAR; }
    PG8_BAR;
    if constexpr (Epi::AFTER_DRAIN) { E.fused(acc, cur, wr, wc, fr, fq, lds, wid, lane); S.done(cur); }
#undef PG8_SA
#undef PG8_SB
#undef PG8_STAGE
#undef PG8_LDA
#undef PG8_LDB
#undef PG8_MMA
#undef PG8_WAIT_V
#undef PG8_WAIT_L
#undef PG8_BAR
#undef PG8_SCHED
}

template <int CB, int KIND, int ACT, int KC  , class Epi>
__device__ __forceinline__ void small_gemm(PG8_LAS unsigned char* lds, const bf16_t* A  , int lda, const bf16_t* Bt, int K, int row_base  , int t  , const Epi& E) {
    int tid_ = threadIdx.x; asm volatile("" : "+v"(tid_));
    const int lane = tid_ & 63, wid = __builtin_amdgcn_readfirstlane(tid_ >> 6), li = lane & 15, kg = lane >> 4;
    const int rb = t >> 4, cb = t & 15;
    const int col0 = cb * (16 * CB);
    constexpr int RS = 2 * KC + 16, ROWS = 128 + 16 * CB, BUF = ROWS * RS; constexpr int CPR = KC / 8  , RPP = 512 / CPR  ;
    constexpr int NA = 128 / RPP, NB = (16 * CB) / RPP;
    const int srow = tid_ / CPR, sch = tid_ % CPR;
    const bf16_t* ag = A + (size_t)(rb * 128 + srow) * lda + sch * 8;
    const bf16_t* bg = Bt + (size_t)(col0 + srow) * K + sch * 8;
    const unsigned sdst = (unsigned)(srow * RS + sch * 16);
#define SG_BAR() do { asm volatile("s_waitcnt lgkmcnt(0)" ::: "memory"); __builtin_amdgcn_s_barrier(); asm volatile("" ::: "memory"); } while (0)
    bf16x8 ra0[NA], rb0[NB], ra1[NA], rb1[NB];
#define SG_LOAD(ra, rbb, k0) do { _Pragma("unroll") for (int i = 0; i < NA; ++i) ra[i] = *(const bf16x8*)(ag + (size_t)(RPP * i) * lda + (k0)); \
        _Pragma("unroll") for (int i = 0; i < NB; ++i) rbb[i] = *(const bf16x8*)(bg + (size_t)(RPP * i) * K + (k0)); } while (0)
#define SG_STORE(ra, rbb, buf) do { _Pragma("unroll") for (int i = 0; i < NA; ++i) *(PG8_LAS bf16x8*)(lds + (buf) * BUF + sdst + (RPP * i) * RS) = ra[i]; \
        _Pragma("unroll") for (int i = 0; i < NB; ++i) *(PG8_LAS bf16x8*)(lds + (buf) * BUF + sdst + (128 + RPP * i) * RS) = rbb[i]; } while (0)
#define SG_COMPUTE(buf) do { _Pragma("unroll") for (int s = 0; s < KC / 32; ++s) { \
            const bf16x8 a = *(const PG8_LAS bf16x8*)(lds + (buf) * BUF + fa + s * 64); \
            _Pragma("unroll") for (int j = 0; j < CB; ++j) { const bf16x8 bq = *(const PG8_LAS bf16x8*)(lds + (buf) * BUF + fb + j * 16 * RS + s * 64); \
                acc[j] = __builtin_amdgcn_mfma_f32_16x16x32_bf16(bq, a, acc[j], 0, 0, 0); } } } while (0)
    f32x4 acc[CB];
#pragma unroll
    for (int j = 0; j < CB; ++j) acc[j] = (f32x4){0.f, 0.f, 0.f, 0.f};
    const unsigned fa = (unsigned)((wid * 16 + li) * RS + kg * 16), fb = (unsigned)((128 + li) * RS + kg * 16);
    const int nc = K / KC;
    SG_LOAD(ra0, rb0, 0); SG_LOAD(ra1, rb1, KC); SG_STORE(ra0, rb0, 0);
    SG_BAR();
    for (int c = 0; c < nc; c += 2) {
        if (c + 2 < nc) SG_LOAD(ra0, rb0, (c + 2) * KC);
        SG_COMPUTE(0);
        SG_STORE(ra1, rb1, 1);
        SG_BAR();
        if (c + 3 < nc) SG_LOAD(ra1, rb1, (c + 3) * KC);
        SG_COMPUTE(1);
        if (c + 2 < nc) SG_STORE(ra0, rb0, 0);
        SG_BAR();
    }
#undef SG_LOAD
#undef SG_STORE
#undef SG_COMPUTE
#undef SG_BAR
    const int row = row_base + rb * 128 + wid * 16 + li;
    if constexpr (KIND == 0) {
#pragma unroll
        for (int j = 0; j < CB; ++j) inproj_small(E, row, col0 + 16 * j + 4 * kg, acc[j]);
    } else if constexpr (KIND == 1) {
        typedef unsigned u32x2_t __attribute__((ext_vector_type(2)));
        float s = 0.f;
#pragma unroll
        for (int j = 0; j < CB; ++j) { const size_t off = (size_t)row * 1024 + col0 + 16 * j + 4 * kg;
            const u32x2_t xo = *(const u32x2_t*)(E.xb + off);
            f32x4 x = {bf_lo(xo.x), bf_hi(xo.x), bf_lo(xo.y), bf_hi(xo.y)}; x += acc[j];
            u32x2_t xn; xn.x = cvt_pk_bf16(x[0], x[1]); xn.y = cvt_pk_bf16(x[2], x[3]); *(u32x2_t*)(E.xb + off) = xn;
            const float q0 = bf_lo(xn.x), q1 = bf_hi(xn.x), q2 = bf_lo(xn.y), q3 = bf_hi(xn.y); s += (q0 * q0 + q1 * q1) + (q2 * q2 + q3 * q3); }
        s += swz_xor<16>(s);
        if ((kg & 1) == 0) atomicAdd(E.ss_next + row, s);
    } else {
        typedef unsigned u32x2_t __attribute__((ext_vector_type(2)));
        const float rs = row_rstd(E.ss, row) * E.scale;
#pragma unroll
        for (int j = 0; j < CB; ++j) { f32x4 v = acc[j] * rs;
            if (ACT == 1) {
#pragma unroll
                for (int e2 = 0; e2 < 4; ++e2) { const float a2 = fmaxf(v[e2], 0.f); v[e2] = a2 * a2; } }
            u32x2_t w; w.x = cvt_pk_bf16(v[0], v[1]); w.y = cvt_pk_bf16(v[2], v[3]);
            *(u32x2_t*)(E.O + (size_t)row * E.ldc + col0 + 16 * j + 4 * kg) = w; }
    }
}
}
namespace att {
#define ATT_LAS __attribute__((address_space(3)))
typedef unsigned short bf16_t;
typedef ATT_LAS unsigned char* lptr;
typedef const ATT_LAS unsigned char* clptr;
typedef ATT_LAS float* lfptr;
using bf16x8 = __attribute__((ext_vector_type(8))) short;
using s16x4  = __attribute__((ext_vector_type(4))) short;
using f32x16 = __attribute__((ext_vector_type(16))) float;
using f32x4  = __attribute__((ext_vector_type(4))) float;
using u32x4  = __attribute__((ext_vector_type(4))) unsigned;
#define KSWZ(row, colB) ((row) * 256 + ((colB) ^ (((row) & 7) << 4)))
#define SBAR() __builtin_amdgcn_sched_barrier(0)
constexpr int NROWS_P_ATT = 65536;
constexpr int IMG = 16384;
constexpr float THR = 8.0f;
__device__ __forceinline__ int crow(int r, int hi) { return (r & 3) + 8 * (r >> 2) + 4 * hi; }
__device__ __forceinline__ unsigned cvtpk(float lo, float hi) { unsigned r; asm volatile("v_cvt_pk_bf16_f32 %0, %1, %2" : "=v"(r) : "v"(lo), "v"(hi)); return r; }
__device__ __forceinline__ bf16x8 tobf8(f32x4 a, f32x4 b) { u32x4 w = {cvtpk(a[0], a[1]), cvtpk(a[2], a[3]), cvtpk(b[0], b[1]), cvtpk(b[2], b[3])}; return __builtin_bit_cast(bf16x8, w); }
__device__ __forceinline__ int v_st(int k, int c) { const int kk = (k & ~0xC) | ((k & 4) << 1) | ((k & 8) >> 1); return ((kk >> 3) * 4 + (c >> 5)) * 512 + ((kk & 7) * 32 + (c & 31)) * 2; }
__device__ __forceinline__ int v_rd_base(int lane) { return ((lane & 3) << 3) | (((lane >> 2) & 3) << 6) | (((lane >> 4) & 1) << 5) | (((lane >> 5) & 1) << 8); }
constexpr int v_rd_off(int d0, int ks, int half) { return d0 * 512 + ks * 4096 + half * 2048; }
template <int OFF> __device__ __forceinline__ s16x4 tr_read(int vb) { s16x4 r; asm volatile("ds_read_b64_tr_b16 %0, %1 offset:%2" : "=&v"(r) : "v"(vb), "i"(OFF) : "memory"); return r; }
#define WAITV(n) asm volatile("s_waitcnt vmcnt(" #n ")" ::: "memory")
#define WAITL0() asm volatile("s_waitcnt lgkmcnt(0)" ::: "memory")
#define WGBAR() do { asm volatile("s_waitcnt lgkmcnt(0)" ::: "memory"); __builtin_amdgcn_s_barrier(); asm volatile("" ::: "memory"); } while (0)

__device__ __forceinline__ unsigned k_src_off(int wid, int lane, unsigned rs) { const int row = 4 * wid + (lane >> 4); return (unsigned)row * rs + (unsigned)(((lane & 15) ^ (row & 7)) * 16); }
__device__ __forceinline__ unsigned v_src_off(int wid, int lane, unsigned rs) { const int st = 2 * wid + (lane >> 5), kk = (st >> 2) * 8 + ((lane & 31) >> 2), k = (kk & ~0xC) | ((kk & 4) << 1) | ((kk & 8) >> 1);
    return (unsigned)k * rs + (unsigned)(((st & 3) * 32 + (lane & 3) * 8) * 2); }
__device__ __forceinline__ void dma_img(ATT_LAS unsigned char* dst, const char* src, unsigned off, unsigned rs, int wid) {
    __builtin_amdgcn_global_load_lds((const unsigned*)(src + off), (ATT_LAS unsigned*)(dst + wid * 1024), 16, 0, 0);
    __builtin_amdgcn_global_load_lds((const unsigned*)(src + off + 32u * rs), (ATT_LAS unsigned*)(dst + wid * 1024 + 8192), 16, 0, 0);
}

#define PK4(P, BASE, OUT) do { unsigned a0 = cvtpk(P[BASE + 0], P[BASE + 1]), a1 = cvtpk(P[BASE + 2], P[BASE + 3]);   \
    unsigned b0 = cvtpk(P[BASE + 4], P[BASE + 5]), b1 = cvtpk(P[BASE + 6], P[BASE + 7]);                              \
    auto r0 = __builtin_amdgcn_permlane32_swap(a0, b0, false, false); auto r1 = __builtin_amdgcn_permlane32_swap(a1, b1, false, false); \
    u32x4 w = {r0[0], r1[0], r0[1], r1[1]}; OUT = __builtin_bit_cast(bf16x8, w); } while (0)
__device__ __forceinline__ void sm_tile(f32x16& p0, f32x16& p1, float& m_reg, float& l_reg, float& alpha, bf16x8& pa0, bf16x8& pa1, bf16x8& pa2, bf16x8& pa3) {
    float pmax = p0[0];
#pragma unroll
    for (int r = 1; r < 16; ++r) pmax = fmaxf(pmax, p0[r]);
#pragma unroll
    for (int r = 0; r < 16; ++r) pmax = fmaxf(pmax, p1[r]);
    { auto rr = __builtin_amdgcn_permlane32_swap(__float_as_uint(pmax), __float_as_uint(pmax), false, false); pmax = fmaxf(__uint_as_float(rr[0]), __uint_as_float(rr[1])); }
    float mn;
    if (__builtin_expect(__all(pmax - m_reg <= THR), 1)) { mn = m_reg; alpha = 1.f; }
    else { mn = fmaxf(m_reg, pmax); alpha = __builtin_amdgcn_exp2f(m_reg - mn); m_reg = mn; }
#pragma unroll
    for (int r = 0; r < 16; ++r) p0[r] = __builtin_amdgcn_exp2f(p0[r] - mn);
#pragma unroll
    for (int r = 0; r < 16; ++r) p1[r] = __builtin_amdgcn_exp2f(p1[r] - mn);
    float ps = 0.f;
#pragma unroll
    for (int r = 0; r < 16; ++r) ps += p0[r];
#pragma unroll
    for (int r = 0; r < 16; ++r) ps += p1[r];
    { auto rr = __builtin_amdgcn_permlane32_swap(__float_as_uint(ps), __float_as_uint(ps), false, false); ps = __uint_as_float(rr[0]) + __uint_as_float(rr[1]); }
    l_reg = l_reg * alpha + ps;
    PK4(p0, 0, pa0); PK4(p0, 8, pa1); PK4(p1, 0, pa2); PK4(p1, 8, pa3);
}
template <int D0LO> __device__ __forceinline__ void qkt4(f32x16& p0, f32x16& p1, clptr Ks, const bf16x8* qr, int r32, int hi) {
    p0 = f32x16{}; p1 = f32x16{};
#pragma unroll
    for (int d0 = D0LO; d0 < D0LO + 4; ++d0) { const int cb = (d0 * 16 + hi * 8) * 2;
        const bf16x8 b0 = *(const ATT_LAS bf16x8*)(Ks + KSWZ(r32, cb));
        const bf16x8 b1 = *(const ATT_LAS bf16x8*)(Ks + KSWZ(32 + r32, cb));
        p0 = __builtin_amdgcn_mfma_f32_32x32x16_bf16(b0, qr[d0], p0, 0, 0, 0);
        p1 = __builtin_amdgcn_mfma_f32_32x32x16_bf16(b1, qr[d0], p1, 0, 0, 0); }
}
__device__ __forceinline__ void qkt8_acc(f32x16& p0, f32x16& p1, clptr Ks, const bf16x8* qr, int r32, int hi) {
#pragma unroll
    for (int d0 = 0; d0 < 8; ++d0) { const int cb = (d0 * 16 + hi * 8) * 2;
        const bf16x8 b0 = *(const ATT_LAS bf16x8*)(Ks + KSWZ(r32, cb));
        const bf16x8 b1 = *(const ATT_LAS bf16x8*)(Ks + KSWZ(32 + r32, cb));
        p0 = __builtin_amdgcn_mfma_f32_32x32x16_bf16(b0, qr[d0], p0, 0, 0, 0);
        p1 = __builtin_amdgcn_mfma_f32_32x32x16_bf16(b1, qr[d0], p1, 0, 0, 0); }
}
#define PKV(L, H) (bf16x8){L[0], L[1], L[2], L[3], H[0], H[1], H[2], H[3]}
template <int D0> __device__ __forceinline__ void pv2_one(f32x16& oa, f32x16& ob, int vb, const bf16x8* pa, const bf16x8* pb) {
    const s16x4 l0 = tr_read<v_rd_off(D0, 0, 0)>(vb), h0 = tr_read<v_rd_off(D0, 0, 1)>(vb), l1 = tr_read<v_rd_off(D0, 1, 0)>(vb), h1 = tr_read<v_rd_off(D0, 1, 1)>(vb);
    const s16x4 l2 = tr_read<v_rd_off(D0, 2, 0)>(vb), h2 = tr_read<v_rd_off(D0, 2, 1)>(vb), l3 = tr_read<v_rd_off(D0, 3, 0)>(vb), h3 = tr_read<v_rd_off(D0, 3, 1)>(vb);
    asm volatile("s_waitcnt lgkmcnt(0)" ::: "memory"); SBAR();
    const bf16x8 v0 = PKV(l0, h0), v1 = PKV(l1, h1), v2 = PKV(l2, h2), v3 = PKV(l3, h3);
    oa = __builtin_amdgcn_mfma_f32_32x32x16_bf16(pa[0], v0, oa, 0, 0, 0); ob = __builtin_amdgcn_mfma_f32_32x32x16_bf16(pb[0], v0, ob, 0, 0, 0);
    oa = __builtin_amdgcn_mfma_f32_32x32x16_bf16(pa[1], v1, oa, 0, 0, 0); ob = __builtin_amdgcn_mfma_f32_32x32x16_bf16(pb[1], v1, ob, 0, 0, 0);
    oa = __builtin_amdgcn_mfma_f32_32x32x16_bf16(pa[2], v2, oa, 0, 0, 0); ob = __builtin_amdgcn_mfma_f32_32x32x16_bf16(pb[2], v2, ob, 0, 0, 0);
    oa = __builtin_amdgcn_mfma_f32_32x32x16_bf16(pa[3], v3, oa, 0, 0, 0); ob = __builtin_amdgcn_mfma_f32_32x32x16_bf16(pb[3], v3, ob, 0, 0, 0);
}
template <int D0> __device__ __forceinline__ void pv1_one(f32x16& oa, int vb, const bf16x8* pa) {
    const s16x4 l0 = tr_read<v_rd_off(D0, 0, 0)>(vb), h0 = tr_read<v_rd_off(D0, 0, 1)>(vb), l1 = tr_read<v_rd_off(D0, 1, 0)>(vb), h1 = tr_read<v_rd_off(D0, 1, 1)>(vb);
    const s16x4 l2 = tr_read<v_rd_off(D0, 2, 0)>(vb), h2 = tr_read<v_rd_off(D0, 2, 1)>(vb), l3 = tr_read<v_rd_off(D0, 3, 0)>(vb), h3 = tr_read<v_rd_off(D0, 3, 1)>(vb);
    asm volatile("s_waitcnt lgkmcnt(0)" ::: "memory"); SBAR();
    oa = __builtin_amdgcn_mfma_f32_32x32x16_bf16(pa[0], PKV(l0, h0), oa, 0, 0, 0);
    oa = __builtin_amdgcn_mfma_f32_32x32x16_bf16(pa[1], PKV(l1, h1), oa, 0, 0, 0);
    oa = __builtin_amdgcn_mfma_f32_32x32x16_bf16(pa[2], PKV(l2, h2), oa, 0, 0, 0);
    oa = __builtin_amdgcn_mfma_f32_32x32x16_bf16(pa[3], PKV(l3, h3), oa, 0, 0, 0);
}

struct VSet { s16x4 l0, h0, l1, h1, l2, h2, l3, h3; };
typedef short v4i16_t __attribute__((ext_vector_type(4)));
template <int OFF> __device__ __forceinline__ s16x4 tr_read_b(int vb) {
    return __builtin_bit_cast(s16x4, __builtin_amdgcn_ds_read_tr16_b64_v4i16((ATT_LAS v4i16_t*)(uintptr_t)(unsigned)(vb + OFF))); }
template <int D0> __device__ __forceinline__ void v_issue(VSet& v, int vb) {
    v.l0 = tr_read_b<v_rd_off(D0, 0, 0)>(vb); v.h0 = tr_read_b<v_rd_off(D0, 0, 1)>(vb); v.l1 = tr_read_b<v_rd_off(D0, 1, 0)>(vb); v.h1 = tr_read_b<v_rd_off(D0, 1, 1)>(vb);
    v.l2 = tr_read_b<v_rd_off(D0, 2, 0)>(vb); v.h2 = tr_read_b<v_rd_off(D0, 2, 1)>(vb); v.l3 = tr_read_b<v_rd_off(D0, 3, 0)>(vb); v.h3 = tr_read_b<v_rd_off(D0, 3, 1)>(vb);
}
__device__ __forceinline__ void v_mma(f32x16& oa, const VSet& v, const bf16x8* pa) {
    oa = __builtin_amdgcn_mfma_f32_32x32x16_bf16(pa[0], PKV(v.l0, v.h0), oa, 0, 0, 0);
    oa = __builtin_amdgcn_mfma_f32_32x32x16_bf16(pa[1], PKV(v.l1, v.h1), oa, 0, 0, 0);
    oa = __builtin_amdgcn_mfma_f32_32x32x16_bf16(pa[2], PKV(v.l2, v.h2), oa, 0, 0, 0);
    oa = __builtin_amdgcn_mfma_f32_32x32x16_bf16(pa[3], PKV(v.l3, v.h3), oa, 0, 0, 0);
}
#define WAITL(n) asm volatile("s_waitcnt lgkmcnt(" #n ")" ::: "memory")
__device__ __forceinline__ void pv_pipe(f32x16* o, int vb, const bf16x8* pa, VSet& A, VSet& B) {
    SBAR(); v_mma(o[0], A, pa); v_issue<2>(A, vb); SBAR();
    v_mma(o[1], B, pa); v_issue<3>(B, vb); SBAR();
    v_mma(o[2], A, pa); SBAR();
    v_mma(o[3], B, pa); SBAR();
}
constexpr int WSF_OFF = 131072 + 1024;
constexpr int Q_OFF = 98304;
constexpr int SLOT = 32768;
struct FState { f32x16 o[4]; f32x16 negm; float m, l; };
__device__ __forceinline__ void partialSM_first(f32x16& p0, f32x16& p1, float& m_reg, f32x16& negm) {
    float pmax = p0[0];
#pragma unroll
    for (int r = 1; r < 16; ++r) pmax = fmaxf(pmax, p0[r]);
#pragma unroll
    for (int r = 0; r < 16; ++r) pmax = fmaxf(pmax, p1[r]);
    { auto rr = __builtin_amdgcn_permlane32_swap(__float_as_uint(pmax), __float_as_uint(pmax), false, false); pmax = fmaxf(__uint_as_float(rr[0]), __uint_as_float(rr[1])); }
    m_reg = pmax;
#pragma unroll
    for (int r = 0; r < 16; ++r) negm[r] = -pmax;
    asm volatile("" : "+v"(negm));
#pragma unroll
    for (int r = 0; r < 16; ++r) { p0[r] -= pmax; p1[r] -= pmax; }
#pragma unroll
    for (int r = 0; r < 16; ++r) p0[r] = __builtin_amdgcn_exp2f(p0[r]);
}
__device__ __forceinline__ void partialSM(f32x16& p0, f32x16& p1, float& m_reg, float& alpha, f32x16& negm) {
    float pmax = p0[0];
#pragma unroll
    for (int r = 1; r < 16; ++r) pmax = fmaxf(pmax, p0[r]);
#pragma unroll
    for (int r = 0; r < 16; ++r) pmax = fmaxf(pmax, p1[r]);
    { auto rr = __builtin_amdgcn_permlane32_swap(__float_as_uint(pmax), __float_as_uint(pmax), false, false); pmax = fmaxf(__uint_as_float(rr[0]), __uint_as_float(rr[1])); }
    if (__builtin_expect(__all(pmax <= THR), 1)) { alpha = 1.f; }
    else { const float dl = fmaxf(pmax, 0.f); m_reg += dl; alpha = __builtin_amdgcn_exp2f(-dl);
#pragma unroll
        for (int r = 0; r < 16; ++r) { p0[r] -= dl; p1[r] -= dl; negm[r] = -m_reg; }
        asm volatile("" : "+v"(negm)); }
#pragma unroll
    for (int r = 0; r < 16; ++r) p0[r] = __builtin_amdgcn_exp2f(p0[r]);
}
__device__ __forceinline__ void finishSM(f32x16& p0, f32x16& p1, float alpha, float& l_reg, bf16x8* pa) {
#pragma unroll
    for (int r = 0; r < 16; ++r) p1[r] = __builtin_amdgcn_exp2f(p1[r]);
    float ps = 0.f;
#pragma unroll
    for (int r = 0; r < 16; ++r) ps += p0[r];
#pragma unroll
    for (int r = 0; r < 16; ++r) ps += p1[r];
    { auto rr = __builtin_amdgcn_permlane32_swap(__float_as_uint(ps), __float_as_uint(ps), false, false); ps = __uint_as_float(rr[0]) + __uint_as_float(rr[1]); }
    l_reg = l_reg * alpha + ps;
    PK4(p0, 0, pa[0]); PK4(p0, 8, pa[1]); PK4(p1, 0, pa[2]); PK4(p1, 8, pa[3]);
}
__device__ __forceinline__ void qkt64(f32x16& p0, f32x16& p1, clptr Ks, clptr qr  , const f32x16& cin  , int r32, int hi) {
#pragma unroll
    for (int d0 = 0; d0 < 4; ++d0) { const int cb = (d0 * 16 + hi * 8) * 2;
        const bf16x8 b0 = *(const ATT_LAS bf16x8*)(Ks + KSWZ(r32, cb));
        const bf16x8 b1 = *(const ATT_LAS bf16x8*)(Ks + KSWZ(32 + r32, cb));
        const bf16x8 q = *(const ATT_LAS bf16x8*)(qr + d0 * 1024);
        if (d0 == 0) { p0 = __builtin_amdgcn_mfma_f32_32x32x16_bf16(b0, q, cin, 0, 0, 0); p1 = __builtin_amdgcn_mfma_f32_32x32x16_bf16(b1, q, cin, 0, 0, 0); }
        else { p0 = __builtin_amdgcn_mfma_f32_32x32x16_bf16(b0, q, p0, 0, 0, 0); p1 = __builtin_amdgcn_mfma_f32_32x32x16_bf16(b1, q, p1, 0, 0, 0); } }
}
__device__ __forceinline__ void pv_all(f32x16* o, int vb, const bf16x8* pa) { pv1_one<0>(o[0], vb, pa); pv1_one<1>(o[1], vb, pa); pv1_one<2>(o[2], vb, pa); pv1_one<3>(o[3], vb, pa); }
__device__ __forceinline__ void resc(f32x16* o, float a, lfptr wsf, int r32, int hi) {
    if (__any(a < 1.f)) { if (hi == 0) wsf[r32] = a; WAITL0();
#pragma unroll
        for (int r = 0; r < 16; ++r) { const float f = wsf[crow(r, hi)];
#pragma unroll
            for (int d = 0; d < 4; ++d) o[d][r] *= f; }
        WAITL0(); }
}
#define PV_TILE(vb_) pv_all(S.o, (vb_), pa)
#define FLASH_LOOP(NT_, MASKLAST_, SYNC_, LATE_) do { \
    f32x16 pA0, pA1, pB0, pB1; float alA, alB; bf16x8 pa[4]; \
    int sK = 0, sV = 0;                                   \
    SYNC_(0); LATE_(0); \
    qkt64(pA0, pA1, kbase + sK, qr, S.negm, r32, hi); partialSM_first(pA0, pA1, S.m, S.negm); alA = 1.f; \
    int t = 1; \
    for (; t + 1 < (NT_); t += 2) { \
        sV = sK; sK = (sK == 2 * SLOT) ? 0 : sK + SLOT; SYNC_(t); \
        SBAR(); qkt64(pB0, pB1, kbase + sK, qr, S.negm, r32, hi); LATE_(t); finishSM(pA0, pA1, alA, S.l, pa); SBAR(); \
        PV_TILE(vbase + sV); partialSM(pB0, pB1, S.m, alB, S.negm); resc(S.o, alB, wsf, r32, hi); \
        sV = sK; sK = (sK == 2 * SLOT) ? 0 : sK + SLOT; SYNC_(t + 1); \
        SBAR(); qkt64(pA0, pA1, kbase + sK, qr, S.negm, r32, hi); LATE_(t + 1); finishSM(pB0, pB1, alB, S.l, pa); SBAR(); \
        PV_TILE(vbase + sV); partialSM(pA0, pA1, S.m, alA, S.negm); resc(S.o, alA, wsf, r32, hi); \
    } \
    if (t < (NT_)) { \
        sV = sK; sK = (sK == 2 * SLOT) ? 0 : sK + SLOT; SYNC_(t); \
        SBAR(); qkt64(pB0, pB1, kbase + sK, qr, S.negm, r32, hi); LATE_(t); \
        if (MASKLAST_) { _Pragma("unroll") for (int r = 0; r < 16; ++r) { pB0[r] = -1e30f; pB1[r] = -1e30f; } } \
        finishSM(pA0, pA1, alA, S.l, pa); SBAR(); \
        PV_TILE(vbase + sV); partialSM(pB0, pB1, S.m, alB, S.negm); resc(S.o, alB, wsf, r32, hi); \
        finishSM(pB0, pB1, alB, S.l, pa); SBAR(); PV_TILE(vbase + sK); \
    } else { \
        finishSM(pA0, pA1, alA, S.l, pa); SBAR(); PV_TILE(vbase + sK); \
    } } while (0)

#define FLASH_LOOP_B(NT_, MASKLAST_, SYNC_, LATE_) do { \
    f32x16 pA0, pA1, pB0, pB1; float alA, alB; bf16x8 pa[4]; \
    int sK = 0, sV = 0; \
    SYNC_(0); LATE_(0); \
    qkt64(pA0, pA1, kbase + sK, qr, S.negm, r32, hi); partialSM_first(pA0, pA1, S.m, S.negm); alA = 1.f; \
    int t = 1; \
    for (; t + 1 < (NT_); t += 2) { \
        sV = sK; sK = (sK == 2 * SLOT) ? 0 : sK + SLOT; SYNC_(t); \
        SBAR(); finishSM(pA0, pA1, alA, S.l, pa); SBAR(); LATE_(t); qkt64(pB0, pB1, kbase + sK, qr, S.negm, r32, hi); SBAR(); partialSM(pB0, pB1, S.m, alB, S.negm); SBAR(); \
        PV_TILE(vbase + sV); resc(S.o, alB, wsf, r32, hi); \
        sV = sK; sK = (sK == 2 * SLOT) ? 0 : sK + SLOT; SYNC_(t + 1); \
        SBAR(); finishSM(pB0, pB1, alB, S.l, pa); SBAR(); LATE_(t + 1); qkt64(pA0, pA1, kbase + sK, qr, S.negm, r32, hi); SBAR(); partialSM(pA0, pA1, S.m, alA, S.negm); SBAR(); \
        PV_TILE(vbase + sV); resc(S.o, alA, wsf, r32, hi); \
    } \
    if (t < (NT_)) { \
        sV = sK; sK = (sK == 2 * SLOT) ? 0 : sK + SLOT; SYNC_(t); \
        SBAR(); finishSM(pA0, pA1, alA, S.l, pa); SBAR(); LATE_(t); qkt64(pB0, pB1, kbase + sK, qr, S.negm, r32, hi); SBAR(); \
        if (MASKLAST_) { _Pragma("unroll") for (int r = 0; r < 16; ++r) { pB0[r] = -1e30f; pB1[r] = -1e30f; } } \
        partialSM(pB0, pB1, S.m, alB, S.negm); SBAR(); \
        PV_TILE(vbase + sV); resc(S.o, alB, wsf, r32, hi); \
        finishSM(pB0, pB1, alB, S.l, pa); SBAR(); PV_TILE(vbase + sK); \
    } else { \
        finishSM(pA0, pA1, alA, S.l, pa); SBAR(); PV_TILE(vbase + sK); \
    } } while (0)

__device__ __forceinline__ void diff_finish2(FState& S, lptr lds, int map, int qblk, bool active, float lam, float post_scale, const float* subg, bf16_t* outp  ,
                                             lfptr wsf, int lane, int r32, int hi) {
    lfptr stash = (lfptr)lds + qblk * 4096 + lane;
    if (active && map == 1) {
        if (hi == 0) wsf[r32] = lam / S.l;
        WAITL0();
#pragma unroll
        for (int r = 0; r < 16; ++r) { const float f = wsf[crow(r, hi)];
#pragma unroll
            for (int d = 0; d < 4; ++d) stash[(d * 16 + r) * 64] = S.o[d][r] * f; }
    }
    WGBAR();
    if (active && map == 0) {
        if (hi == 0) wsf[r32] = 1.0f / S.l;
        WAITL0();
        float g[4];
#pragma unroll
        for (int d = 0; d < 4; ++d) g[d] = subg[32 * d + r32] * post_scale;
        unsigned lane_off = (unsigned)(4 * hi) * (unsigned)ZLD + (unsigned)r32;
#pragma unroll
        for (int r = 0; r < 16; ++r) {
            asm volatile("" : "+v"(lane_off));
            const float c1 = wsf[crow(r, hi)];
            float v[4]; float ss = 0.f;
#pragma unroll
            for (int d = 0; d < 4; ++d) { v[d] = S.o[d][r] * c1 - stash[(d * 16 + r) * 64]; ss += v[d] * v[d]; }
            ss = xsum32(ss);
            const float rs = 1.0f / sqrtf(ss * (1.0f / 128.0f) + 1e-5f);
#pragma unroll
            for (int d = 0; d < 4; d += 2) { const unsigned w2 = cvtpk(v[d] * rs * g[d], v[d + 1] * rs * g[d + 1]);
                outp[lane_off + (unsigned)(((r & 3) + 8 * (r >> 2)) * ZLD + 32 * d)] = (unsigned short)(w2 & 0xffffu); outp[lane_off + (unsigned)(((r & 3) + 8 * (r >> 2)) * ZLD + 32 * (d + 1))] = (unsigned short)(w2 >> 16); }
        }
    }
    WAITV(0); WGBAR();
}

__device__ __forceinline__ void diff_prompt_unit(lptr lds, const bf16_t* Qa, const bf16_t* Ka, const bf16_t* Va, bf16_t* mix, int b, int h, int qb, float lam, float post_scale, const float* subg) {
    int tid = threadIdx.x; asm volatile("" : "+v"(tid));
    const int lane = tid & 63, r32 = lane & 31, hi = lane >> 5; const int wid = __builtin_amdgcn_readfirstlane(tid >> 6);
    const int map = wid >> 2, qblk = wid & 3;
    const size_t rowbase = (size_t)b * 8192; const int q0 = qb * 128;
    lfptr wsf = (lfptr)(lds + WSF_OFF) + wid * 64;
    const unsigned koff = k_src_off(wid, lane, 2u * ZLD), voff = v_src_off(wid, lane, 2u * ZLD);
    const char* Kg = (const char*)(Ka + rowbase * ZLD + h * 128); const char* Vg = (const char*)(Va + rowbase * ZLD + h * 128);
    const int NT = 2 * qb + 2; const bool masklast = (qblk >> 1) == 0;
    const lptr qr = lds + Q_OFF + wid * 4096 + lane * 16;
    { const bf16_t* Qw = Qa + (rowbase + q0 + qblk * 32 + r32) * ZLD + h * 128 + map * 64 + hi * 8;
#pragma unroll
      for (int d0 = 0; d0 < 4; ++d0) *(ATT_LAS bf16x8*)(qr + d0 * 1024) = *reinterpret_cast<const bf16x8*>(Qw + d0 * 16); }
    WAITV(0);
#define DMA_TILE(t, sofs) do { dma_img(lds + (sofs), Kg + (size_t)(t) * (128 * ZLD), koff, 2u * ZLD, wid); dma_img(lds + (sofs) + IMG, Vg + (size_t)(t) * (128 * ZLD), voff, 2u * ZLD, wid); } while (0)
    DMA_TILE(0, 0);
    FState S;
#pragma unroll
    for (int d = 0; d < 4; ++d) S.o[d] = f32x16{};
    S.negm = f32x16{}; S.m = 0.f; S.l = 0.f;
    const clptr kbase = lds + map * 128;
    const int vbase = (int)(unsigned)(uintptr_t)(lds + IMG) + v_rd_base(lane);
#define SYNC_W(t) do { WAITV(0); WGBAR(); } while (0)
#define SYNC_D(t) do { if ((t) + 1 < NT) { const int sn_ = (sK == 2 * SLOT) ? 0 : sK + SLOT; DMA_TILE((t) + 1, sn_); } } while (0)
#define SYNC_P(t) do { SYNC_W(t); SYNC_D(t); } while (0)
    if ((((wid >> 2) ^ wid) & 1) == 0) FLASH_LOOP(NT, masklast, SYNC_W, SYNC_D);
    else FLASH_LOOP_B(NT, masklast, SYNC_W, SYNC_D);
#undef SYNC_P
#undef SYNC_W
#undef SYNC_D
#undef DMA_TILE
    WGBAR();
    diff_finish2(S, lds, map, qblk, true, lam, post_scale, subg, mix + (rowbase + q0 + qblk * 32) * ZLD + h * 128, wsf, lane, r32, hi);
}

__device__ __forceinline__ void diff_sample_unit(lptr lds, const bf16_t* Qa, const bf16_t* Ka, const bf16_t* Va, const float* ck, const float* cv, bf16_t* mix, int b, int h, float lam, float post_scale, const float* subg) {
    int tid = threadIdx.x; asm volatile("" : "+v"(tid));
    const int lane = tid & 63, r32 = lane & 31, hi = lane >> 5; const int wid = __builtin_amdgcn_readfirstlane(tid >> 6);
    const int map = wid >> 2, qblk = wid & 3;
    const size_t row0 = (size_t)NROWS_P_ATT + (size_t)b * 64;
    lfptr wsf = (lfptr)(lds + WSF_OFF) + wid * 64;
    constexpr int NT = 33;
    const float* ckb = ck + (size_t)b * 2048 * 512; const float* cvb = cv + (size_t)b * 2048 * 512;
    FState S;
#define S_ZERO() do { _Pragma("unroll") for (int d = 0; d < 4; ++d) S.o[d] = f32x16{}; S.negm = f32x16{}; S.m = 0.f; S.l = 0.f; } while (0)
    if (wid & 2) {
        int lt = (wid >> 2) * 128 + (tid & 127); asm volatile("" : "+v"(lt));
        const int sr = lt >> 4, sc = (lt & 15) * 8;
        const unsigned kofs = (unsigned)sr * 512u + (unsigned)((sc >> 6) * 256 + h * 64 + (sc & 63));
        const unsigned vofs = (unsigned)sr * 512u + (unsigned)(h * 128 + sc);
        const unsigned kst = (unsigned)KSWZ(sr, sc * 2);
        f32x4 kr0[4][2], vr0[4][2], kr1[4][2], vr1[4][2];
#define LD_TILE(kr, vr, t) do { const float* kt_ = ckb + (size_t)(t) * 64 * 512; const float* vt_ = cvb + (size_t)(t) * 64 * 512; \
            _Pragma("unroll") for (int j = 0; j < 4; ++j) { const float* kp = kt_ + (kofs + (unsigned)(j * 16 * 512)); const float* vp = vt_ + (vofs + (unsigned)(j * 16 * 512)); \
                kr[j][0] = *(const f32x4*)kp; kr[j][1] = *(const f32x4*)(kp + 4); vr[j][0] = *(const f32x4*)vp; vr[j][1] = *(const f32x4*)(vp + 4); } } while (0)
#define ST_TILE(kr, vr, sofs) do { _Pragma("unroll") for (int j = 0; j < 4; ++j) { \
                *(ATT_LAS bf16x8*)(lds + (sofs) + kst + j * 4096) = tobf8(kr[j][0], kr[j][1]); *(ATT_LAS bf16x8*)(lds + (sofs) + IMG + v_st(sr + 16 * j, sc)) = tobf8(vr[j][0], vr[j][1]); } } while (0)
#define NEXT_SLOT(x) ((x) == 2 * SLOT ? 0 : (x) + SLOT)
        LD_TILE(kr0, vr0, 0); ST_TILE(kr0, vr0, 0); LD_TILE(kr1, vr1, 1); LD_TILE(kr0, vr0, 2);
        WGBAR();
        int sofs = SLOT;
        for (int t = 1; t < 31; t += 2) {
            ST_TILE(kr1, vr1, sofs); if (t + 2 < 32) LD_TILE(kr1, vr1, t + 2); sofs = NEXT_SLOT(sofs);
            WGBAR();
            ST_TILE(kr0, vr0, sofs); if (t + 3 < 32) LD_TILE(kr0, vr0, t + 3); sofs = NEXT_SLOT(sofs);
            WGBAR();
        }
        ST_TILE(kr1, vr1, sofs); sofs = NEXT_SLOT(sofs);
        WGBAR();
        { const bf16_t* kn = Ka + row0 * ZLD; const bf16_t* vn = Va + row0 * ZLD;
#pragma unroll
            for (int j = 0; j < 4; ++j) { const unsigned o = (unsigned)(sr + 16 * j) * (unsigned)ZLD + (unsigned)(h * 128 + sc);
                *(ATT_LAS bf16x8*)(lds + sofs + kst + j * 4096) = *(const bf16x8*)(kn + o);
                *(ATT_LAS bf16x8*)(lds + sofs + IMG + v_st(sr + 16 * j, sc)) = *(const bf16x8*)(vn + o); } }
        WGBAR();
#undef NEXT_SLOT
#undef LD_TILE
#undef ST_TILE
        S_ZERO();
    } else {
        S_ZERO();
        const lptr qr = lds + Q_OFF + wid * 4096 + lane * 16;
        { const bf16_t* Qw = Qa + (row0 + (qblk & 1) * 32 + r32) * ZLD + h * 128 + map * 64 + hi * 8;
#pragma unroll
          for (int d0 = 0; d0 < 4; ++d0) *(ATT_LAS bf16x8*)(qr + d0 * 1024) = *reinterpret_cast<const bf16x8*>(Qw + d0 * 16); }
        const clptr kbase = lds + map * 128;
        const int vbase = (int)(unsigned)(uintptr_t)(lds + IMG) + v_rd_base(lane);
#define SYNC_S(t) do { WGBAR(); } while (0)
#define SYNC_N(t) do { } while (0)
        if (map == 0) FLASH_LOOP(NT, false, SYNC_S, SYNC_N); else FLASH_LOOP_B(NT, false, SYNC_S, SYNC_N);
#undef SYNC_N
#undef SYNC_S
    }
    WGBAR();
    diff_finish2(S, lds, map, qblk, (wid & 2) == 0, lam, post_scale, subg, mix + (row0 + (qblk & 1) * 32) * ZLD + h * 128, wsf, lane, r32, hi);
}

template <int NACT> __device__ __forceinline__ void cross_unit(lptr lds, const bf16_t* Qrows  , const bf16_t* MK, const bf16_t* MV, bf16_t* Orows, int h) {
    int tid = threadIdx.x; asm volatile("" : "+v"(tid));
    const int lane = tid & 63, r32 = lane & 31, hi = lane >> 5; const int wid = __builtin_amdgcn_readfirstlane(tid >> 6);
    lfptr wsf = (lfptr)(lds + WSF_OFF) + wid * 64;
    const unsigned koff = k_src_off(wid, lane, 2048u), voff = v_src_off(wid, lane, 2048u);
    const char* Kg = (const char*)(MK + h * 256); const char* Vg = (const char*)(MV + h * 256);
    lptr l3 = lds;
    const bool act = wid < NACT;
    bf16x8 qr[16];
    if (act) { const bf16_t* Qw = Qrows + (size_t)(wid * 32 + r32) * ZLD + h * 256 + hi * 8;
#pragma unroll
        for (int d0 = 0; d0 < 16; ++d0) qr[d0] = *reinterpret_cast<const bf16x8*>(Qw + d0 * 16); }
    else {
#pragma unroll
        for (int d0 = 0; d0 < 16; ++d0) qr[d0] = bf16x8{}; }
#define X_DMA(idx) do { if ((idx) < 8) dma_img(l3 + ((idx) & 3) * IMG, Kg + (size_t)((idx) >> 1) * 64 * 2048 + ((idx) & 1) * 256, koff, 2048u, wid); \
                        else dma_img(l3 + ((idx) & 3) * IMG, Vg + (size_t)(((idx) - 8) & 3) * 64 * 2048 + (((idx) - 8) >> 2) * 256, voff, 2048u, wid); } while (0)
    X_DMA(0); X_DMA(1); X_DMA(2);
    f32x16 s[4][2];
#pragma unroll
    for (int kt = 0; kt < 4; ++kt) { s[kt][0] = f32x16{}; s[kt][1] = f32x16{}; }
#define X_STEP_K(idx) do { WAITV(4); WGBAR(); X_DMA((idx) + 3); if (act) qkt8_acc(s[(idx) >> 1][0], s[(idx) >> 1][1], lds + ((idx) & 3) * IMG, qr + ((idx) & 1) * 8, r32, hi); } while (0)
    X_STEP_K(0); X_STEP_K(1); X_STEP_K(2); X_STEP_K(3); X_STEP_K(4); X_STEP_K(5); X_STEP_K(6); X_STEP_K(7);
#undef X_STEP_K
    bf16x8 pa[4][4]; float inv;
    {
        float pmax = s[0][0][0];
#pragma unroll
        for (int kt = 0; kt < 4; ++kt)
#pragma unroll
            for (int j = 0; j < 2; ++j)
#pragma unroll
                for (int r = 0; r < 16; ++r) pmax = fmaxf(pmax, s[kt][j][r]);
        { auto rr = __builtin_amdgcn_permlane32_swap(__float_as_uint(pmax), __float_as_uint(pmax), false, false); pmax = fmaxf(__uint_as_float(rr[0]), __uint_as_float(rr[1])); }
        float ps = 0.f;
#pragma unroll
        for (int kt = 0; kt < 4; ++kt)
#pragma unroll
            for (int j = 0; j < 2; ++j)
#pragma unroll
                for (int r = 0; r < 16; ++r) { const float e = __builtin_amdgcn_exp2f(s[kt][j][r] - pmax); s[kt][j][r] = e; ps += e; }
        { auto rr = __builtin_amdgcn_permlane32_swap(__float_as_uint(ps), __float_as_uint(ps), false, false); ps = __uint_as_float(rr[0]) + __uint_as_float(rr[1]); }
        inv = 1.0f / ps;
#pragma unroll
        for (int kt = 0; kt < 4; ++kt) { PK4(s[kt][0], 0, pa[kt][0]); PK4(s[kt][0], 8, pa[kt][1]); PK4(s[kt][1], 0, pa[kt][2]); PK4(s[kt][1], 8, pa[kt][3]); }
    }
    WAITL0();
    if (hi == 0) wsf[r32] = inv;
    WAITL0();
    float rli[16];
#pragma unroll
    for (int r = 0; r < 16; ++r) rli[r] = wsf[crow(r, hi)];
    const int vb0 = (int)(unsigned)(uintptr_t)lds + v_rd_base(lane);
    f32x16 o[4];
#define X_STEP_V(idx, WN) do { WAITV(WN); WGBAR(); if ((idx) + 3 < 16) X_DMA((idx) + 3); \
        if ((((idx) - 8) & 3) == 0) { o[0] = f32x16{}; o[1] = f32x16{}; o[2] = f32x16{}; o[3] = f32x16{}; } \
        if (act) { const int vb_ = vb0 + ((idx) & 3) * IMG; const bf16x8* pp_ = pa[((idx) - 8) & 3]; pv1_one<0>(o[0], vb_, pp_); pv1_one<1>(o[1], vb_, pp_); pv1_one<2>(o[2], vb_, pp_); pv1_one<3>(o[3], vb_, pp_); \
            if ((((idx) - 8) & 3) == 3) { bf16_t* op_ = Orows + (size_t)(wid * 32) * ZLD + h * 256 + (((idx) - 8) >> 2) * 128; \
                _Pragma("unroll") for (int r = 0; r < 16; ++r) { const int orow = crow(r, hi); \
                    _Pragma("unroll") for (int d = 0; d < 4; d += 2) { const unsigned w2 = cvtpk(o[d][r] * rli[r], o[d + 1][r] * rli[r]); op_[(size_t)orow * ZLD + 32 * d + r32] = (unsigned short)(w2 & 0xffffu); op_[(size_t)orow * ZLD + 32 * (d + 1) + r32] = (unsigned short)(w2 >> 16); } } } } } while (0)
    X_STEP_V(8, 4); X_STEP_V(9, 4); X_STEP_V(10, 4); X_STEP_V(11, 4); X_STEP_V(12, 4); X_STEP_V(13, 4); X_STEP_V(14, 2); X_STEP_V(15, 0);
#undef X_STEP_V
#undef X_DMA
}
#undef PK4
}

constexpr int NWAVES = 8;
#ifndef MK_PER_PHASE
#define MK_PER_PHASE 0
#endif
constexpr int DM = 1024, BATCH = 8, SEQ = 8192, DEPTH = 2, DEC_BATCH = 32, DEC_SEQ = 64, PAST = 2048, NMEM = 256, DFF = 4096;
constexpr int MP = BATCH * SEQ, MS = DEC_BATCH * DEC_SEQ, MT = MP + MS;
constexpr int NPH = 18;
constexpr size_t O_YP = 0, O_YS = O_YP + (size_t)MP * DM, O_KP = O_YS + (size_t)MS * DM, O_VP = O_KP + (size_t)DEPTH * MP * 512, O_PP = O_VP + (size_t)DEPTH * MP * 512,
                 O_MKP = O_PP + (size_t)DEPTH * BATCH * 15 * 512, O_MVP = O_MKP + (size_t)DEPTH * BATCH * NMEM * DM, O_KS = O_MVP + (size_t)DEPTH * BATCH * NMEM * DM,
                 O_VS = O_KS + (size_t)DEPTH * MS * 512, O_PS = O_VS + (size_t)DEPTH * MS * 512, O_END = O_PS + (size_t)DEPTH * DEC_BATCH * 15 * 512;
constexpr size_t MiB = 1u << 20;
constexpr size_t WS_CTL = 0, CTL_ZERO_BYTES = 4 * MiB;
constexpr size_t WS_SS = 1 * MiB;
constexpr size_t WS_W = 4 * MiB;
constexpr size_t W_IN = 0, W_OUT = 4 * MiB, W_Q = 6 * MiB, W_O = 8 * MiB, W_UP = 10 * MiB, W_DOWN = 18 * MiB, W_LAYER = 26 * MiB, W_KV = 52 * MiB;
constexpr size_t WS_MEMB = 64 * MiB;
constexpr size_t WS_MKP = 68 * MiB, WS_MVP = 76 * MiB;
constexpr size_t WS_MKS = 84 * MiB, WS_MVS = 116 * MiB;
constexpr size_t WS_XB = 148 * MiB;
constexpr size_t WS_Z = 280 * MiB;
constexpr int ZC_QA = 0, ZC_KA = 512, ZC_VA = 1024, ZC_U = 1536, ZC_MIX = 2048, ZC_QX = 0, ZC_OX = 1024;
constexpr size_t WS_END = WS_Z + 528 * MiB;
static_assert((size_t)MT * 512 * 2 == 66 * MiB && (size_t)MT * 4096 * 2 == 528 * MiB, "region sizes");
constexpr int CW_BAR = 4096;
constexpr int CW_TICKET = 16384;
constexpr int RING_BYTES = 131072, LDSCTL_OFF = RING_BYTES, MISC_OFF = LDSCTL_OFF + 320, LDS_BYTES = 147456;

#define GAS __attribute__((address_space(1)))
#define LAS __attribute__((address_space(3)))
typedef unsigned short bf16;
typedef unsigned v4u __attribute__((ext_vector_type(4)));
typedef float f32x4 __attribute__((ext_vector_type(4)));
typedef GAS unsigned gu32;
#define LDS_WAIT() asm volatile("s_waitcnt lgkmcnt(0)" ::: "memory")
#define VM_WAIT() asm volatile("s_waitcnt vmcnt(0)" ::: "memory")
__device__ __forceinline__ unsigned f2bf(float f) { unsigned u = __builtin_bit_cast(unsigned, f); return (u + 0x7fffu + ((u >> 16) & 1u)) >> 16; }
__device__ __forceinline__ unsigned pk2(float lo, float hi) { return f2bf(lo) | (f2bf(hi) << 16); }
__device__ __forceinline__ float bf2f(unsigned short h) { return __builtin_bit_cast(float, (unsigned)h << 16); }
#define XB_TMO      128
#define XB_XCNT(j)  (256  + 64 * (j))
#define XB_XSUB(j)  (1280 + 64 * (j))
#define XB_XGEN(j)  (2304 + 64 * (j))
#define XB_TOP      3328
#define XB_TOPGEN   3392
#define XB_XLOC(j)  (3456 + 64 * (j))
#define XCD_BAR_WORDS 4480
#define XB_SPIN_CAP (1u << 18)

__device__ __forceinline__ unsigned xb_ld(unsigned* p)              { return __hip_atomic_load(p, __ATOMIC_RELAXED, __HIP_MEMORY_SCOPE_AGENT); }
__device__ __forceinline__ unsigned xb_add(unsigned* p, unsigned v) { return __hip_atomic_fetch_add(p, v, __ATOMIC_RELAXED, __HIP_MEMORY_SCOPE_AGENT); }
__device__ __forceinline__ unsigned xb_xcc_id() { return (unsigned)__builtin_amdgcn_s_getreg((3 << 11) | 20) & 0xFu; }
#define XB_SPIN(cond, bar) do { unsigned _sp = 0; while (cond) { __builtin_amdgcn_s_sleep(1); \
    if ((++_sp & 255u) == 0u) { if (xb_ld(&(bar)[XB_TMO])) break; if (_sp > XB_SPIN_CAP) { atomicAdd(&(bar)[XB_TMO], 1u); break; } } } } while (0)

struct XcdBarrier {
    unsigned* bar; unsigned x;
    volatile LAS unsigned* st;
};

__device__ __forceinline__ XcdBarrier xcd_barrier_post(unsigned* bar, volatile LAS unsigned* st) {
    XcdBarrier b; b.bar = bar; b.x = xb_xcc_id(); b.st = st;
    if (threadIdx.x == 0) st[2] = xb_add(&bar[XB_XCNT(b.x)], 1u);
    return b;
}
__device__ __forceinline__ void xcd_barrier_complete(unsigned* bar, unsigned x, unsigned& nloc, unsigned& nx, unsigned& even) {
    const unsigned G = gridDim.x * gridDim.y * gridDim.z;
    unsigned sum, cnt, mine, good, sp = 0u;
    for (;;) {
        sum = 0u; cnt = 0u; mine = 0u; good = 0u;
#pragma unroll
        for (unsigned j = 0; j < 16; ++j) { const unsigned c = xb_ld(&bar[XB_XCNT(j)]); sum += c; cnt += (c > 0u) ? 1u : 0u; mine = (j == x) ? c : mine; good += (c == (j < 8u ? 32u : 0u)) ? 1u : 0u; }
        if (sum == G) break;
        __builtin_amdgcn_s_sleep(1);
        if ((++sp & 255u) == 0u) { if (xb_ld(&bar[XB_TMO])) break; if (sp > XB_SPIN_CAP) { atomicAdd(&bar[XB_TMO], 1u); break; } }
    }
    nloc = mine > 0u ? mine : 1u; nx = cnt > 0u ? cnt : 1u;
    even = (sum == G && G == 256u && good == 16u) ? 1u : 2u;
}

__device__ __forceinline__ void xcd_barrier(const XcdBarrier& b) {
    asm volatile("s_waitcnt vmcnt(0)" ::: "memory");
    __syncthreads();
    if (threadIdx.x == 0) {
        unsigned* bar = b.bar;
        __builtin_amdgcn_s_waitcnt(0);
        unsigned nloc = b.st[0], nx = b.st[1];
        if (nloc == 0u) { unsigned even; xcd_barrier_complete(bar, b.x, nloc, nx, even); b.st[0] = nloc; b.st[1] = nx; b.st[3] = even; }
        const unsigned old = xb_add(&bar[XB_XSUB(b.x)], 1u);
        const unsigned gen = old / nloc;
        if (old + 1u == (gen + 1u) * nloc) {
            __builtin_amdgcn_fence(__ATOMIC_RELEASE, "agent");
            asm volatile("s_waitcnt vmcnt(0)" ::: "memory");
            const unsigned og = xb_add(&bar[XB_TOP], 1u);
            const unsigned tg = og / nx;
            if (og + 1u == (tg + 1u) * nx) xb_add(&bar[XB_TOPGEN], 1u);
            else XB_SPIN(xb_ld(&bar[XB_TOPGEN]) == tg, bar);
            __builtin_amdgcn_fence(__ATOMIC_ACQUIRE, "agent");
            xb_add(&bar[XB_XGEN(b.x)], 1u);
            asm volatile("s_waitcnt vmcnt(0)" ::: "memory");
        } else {
            XB_SPIN(xb_ld(&bar[XB_XGEN(b.x)]) == gen, bar);
            __builtin_amdgcn_fence(__ATOMIC_ACQUIRE, "agent");
            asm volatile("s_waitcnt vmcnt(0)" ::: "memory");
        }
    }
    __syncthreads();
}

__device__ __forceinline__ void xcd_local_barrier(const XcdBarrier& b) {
    asm volatile("s_waitcnt vmcnt(0)" ::: "memory");
    __syncthreads();
    if (threadIdx.x == 0) {
        unsigned* bar = b.bar;
        __builtin_amdgcn_s_waitcnt(0);
        const unsigned old = xb_add(&bar[XB_XLOC(b.x)], 1u);
        const unsigned target = (old / 32u + 1u) * 32u;
        XB_SPIN(xb_ld(&bar[XB_XLOC(b.x)]) < target, bar);
        __builtin_amdgcn_fence(__ATOMIC_ACQUIRE, "agent");
        asm volatile("s_waitcnt vmcnt(0)" ::: "memory");
    }
    __syncthreads();
}

struct Args {
    const float *x_prompt, *x_sample, *cache_k, *cache_v, *state_pool, *cache_mem_k, *cache_mem_v, *mem_prompt;
    const float *norm_mix_g, *w_in, *lam_q, *lam_k, *subln_g, *w_pool, *pool_scale, *w_out, *norm_x_g, *norm_mem_g, *wq_x, *wk_x, *wv_x, *wo_x, *norm_mlp_g, *w_up, *w_down, *final_g;
    float* out; unsigned char* ws; int ph_lo, ph_hi;
};
struct Frame { LAS unsigned char* lds; int vcu, G; };
#define AS4 __attribute__((address_space(4)))
typedef const AS4 unsigned char* kargs_t;
#define AF(field) (*(const AS4 decltype(Args::field)*)(kargs + __builtin_offsetof(Args, field)))

__device__ __forceinline__ float wave_sum(float v) { return xsum64(v); }
__device__ __forceinline__ void transpose_item(const float* W, int N, const float* gain, bf16* WT, int Kout, int row_off, LAS float* scr, int item, int lane) {
    const int nblk = N / 32, kb = item / nblk, nb = item % nblk, k0 = 64 * kb, n0 = 32 * nb;
#pragma unroll
    for (int i = 0; i < 32; ++i) { const int kk = 2 * i + (lane >> 5); float v = W[(size_t)(k0 + kk) * N + n0 + (lane & 31)]; if (gain) v *= gain[k0 + kk]; scr[kk * 33 + (lane & 31)] = v; }
    LDS_WAIT(); asm volatile("" ::: "memory");
    const int c = lane & 7;
#pragma unroll
    for (int j = 0; j < 4; ++j) { const int n = (lane >> 3) + 8 * j; const LAS float* s = scr + (8 * c) * 33 + n;
        v4u o; o.x = pk2(s[0 * 33], s[1 * 33]); o.y = pk2(s[2 * 33], s[3 * 33]); o.z = pk2(s[4 * 33], s[5 * 33]); o.w = pk2(s[6 * 33], s[7 * 33]);
        *(GAS v4u*)(WT + (size_t)(row_off + n0 + n) * Kout + k0 + 8 * c) = o; }
    LDS_WAIT(); asm volatile("" ::: "memory");
}
__device__ __forceinline__ void row_to_bf16(const float* xrow, float* copy, bf16* orow, float* ss_slot, int lane) {
    const GAS f32x4* xr = (const GAS f32x4*)xrow + lane;
    f32x4 v[4]; float s = 0.f;
#pragma unroll
    for (int j = 0; j < 4; ++j) { v[j] = xr[64 * j]; s += (v[j].x * v[j].x + v[j].y * v[j].y) + (v[j].z * v[j].z + v[j].w * v[j].w); }
    s = wave_sum(s);
    if (copy) { GAS f32x4* c = (GAS f32x4*)copy + lane;
#pragma unroll
        for (int j = 0; j < 4; ++j) c[64 * j] = v[j]; }
    GAS unsigned long long* o8 = (GAS unsigned long long*)orow + lane;
#pragma unroll
    for (int j = 0; j < 4; ++j) o8[64 * j] = (unsigned long long)pk2(v[j].x, v[j].y) | ((unsigned long long)pk2(v[j].z, v[j].w) << 32);
    if (lane == 0) *ss_slot = s;
}
__device__ __forceinline__ void p0_prologue(kargs_t kargs, Frame& F0) {
    int t_ = threadIdx.x; asm volatile("" : "+v"(t_));
    const int P_tid = t_, P_lane = t_ & 63, P_wave = __builtin_amdgcn_readfirstlane(t_ >> 6), P_vcu = F0.vcu, P_G = F0.G; LAS unsigned char* const P_lds = F0.lds;
    unsigned char* ws = AF(ws);
    LAS float* scr = (LAS float*)(P_lds + P_wave * 16384);
    const int gw = P_vcu * NWAVES + P_wave, NGW = P_G * NWAVES;
    float* ss = (float*)(ws + WS_SS);
    constexpr int I_IN = 16 * 64, I_OUT = 8 * 32, I_SQ = 16 * 32, I_UP = 16 * 128, I_DN = 64 * 32, I_LAYER = I_IN + I_OUT + 4 * I_SQ + I_UP + I_DN;
    for (int it = gw; it < DEPTH * I_LAYER; it += NGW) {
        const int l = it / I_LAYER; int r = it % I_LAYER; bf16* wl = (bf16*)(ws + WS_W + (size_t)l * W_LAYER); bf16* wkv = (bf16*)(ws + WS_W + W_KV);
        if (r < I_IN) { transpose_item(AF(w_in) + (size_t)l * DM * 2048, 2048, AF(norm_mix_g) + l * DM, (bf16*)((unsigned char*)wl + W_IN), DM, 0, scr, r, P_lane); continue; } r -= I_IN;
        if (r < I_OUT) { transpose_item(AF(w_out) + (size_t)l * DM * DM, DM, nullptr, (bf16*)((unsigned char*)wl + W_OUT), DM, 0, scr, r, P_lane); continue; } r -= I_OUT;
        if (r < I_SQ) { transpose_item(AF(wq_x) + (size_t)l * DM * DM, DM, AF(norm_x_g) + l * DM, (bf16*)((unsigned char*)wl + W_Q), DM, 0, scr, r, P_lane); continue; } r -= I_SQ;
        if (r < I_SQ) { transpose_item(AF(wo_x) + (size_t)l * DM * DM, DM, nullptr, (bf16*)((unsigned char*)wl + W_O), DM, 0, scr, r, P_lane); continue; } r -= I_SQ;
        if (r < I_SQ) { transpose_item(AF(wk_x) + (size_t)l * DM * DM, DM, AF(norm_mem_g) + l * DM, wkv, DM, l * 2048, scr, r, P_lane); continue; } r -= I_SQ;
        if (r < I_SQ) { transpose_item(AF(wv_x) + (size_t)l * DM * DM, DM, AF(norm_mem_g) + l * DM, wkv, DM, l * 2048 + 1024, scr, r, P_lane); continue; } r -= I_SQ;
        if (r < I_UP) { transpose_item(AF(w_up) + (size_t)l * DM * DFF, DFF, AF(norm_mlp_g) + l * DM, (bf16*)((unsigned char*)wl + W_UP), DM, 0, scr, r, P_lane); continue; } r -= I_UP;
        transpose_item(AF(w_down) + (size_t)l * DFF * DM, DM, nullptr, (bf16*)((unsigned char*)wl + W_DOWN), DFF, 0, scr, r, P_lane);
    }
    for (int it = gw; it < DEPTH * 4 * 16 * 16; it += NGW) {
        const int nb = it & 15, cb = (it >> 4) & 15, g = (it >> 8) & 3, l = it >> 10; const int n = nb * 64 + P_lane;
        const float* wp = AF(w_pool) + ((size_t)(l * 4 + g) * 128 + cb * 8) * 128; const float* ps = AF(pool_scale) + l * 512 + g * 128; const float* wo = AF(w_out) + (size_t)l * DM * DM + (size_t)(512 + g * 128) * DM + n;
        float acc[8];
#pragma unroll
        for (int c = 0; c < 8; ++c) acc[c] = 0.f;
#pragma unroll 4
        for (int d = 0; d < 128; ++d) { const float w = wo[(size_t)d * DM] * ps[d];
#pragma unroll
            for (int c = 0; c < 8; ++c) acc[c] += wp[c * 128 + d] * w; }
        bf16* wt = (bf16*)(ws + WS_W + (size_t)l * W_LAYER + W_OUT) + (size_t)n * DM + 512 + g * 128 + cb * 8;
        v4u o0; o0.x = pk2(acc[0], acc[1]); o0.y = pk2(acc[2], acc[3]); o0.z = pk2(acc[4], acc[5]); o0.w = pk2(acc[6], acc[7]);
        *(v4u*)wt = o0;
    }
    for (int m = gw; m < MT; m += NGW) {
        const float* src = m < MP ? AF(x_prompt) + (size_t)m * DM : AF(x_sample) + (size_t)(m - MP) * DM;
        row_to_bf16(src, nullptr, (bf16*)(ws + WS_XB) + (size_t)m * DM, ss + m, P_lane);
    }
    for (int m = gw; m < BATCH * NMEM; m += NGW) row_to_bf16(AF(mem_prompt) + (size_t)m * DM, nullptr, (bf16*)(ws + WS_MEMB) + (size_t)m * DM, ss + 7 * MT + m, P_lane);
}
__device__ __forceinline__ void unpack8(const v4u q, float (&f)[8]) { f[0] = bf2f(q.x & 0xffff); f[1] = bf2f(q.x >> 16); f[2] = bf2f(q.y & 0xffff); f[3] = bf2f(q.y >> 16); f[4] = bf2f(q.z & 0xffff); f[5] = bf2f(q.z >> 16); f[6] = bf2f(q.w & 0xffff); f[7] = bf2f(q.w >> 16); }
__device__ __forceinline__ void pool_ext(const bf16* Useq  , const float* hist  , int i, float (&f)[8]) {
    if (i >= 0) { unpack8(*(const v4u*)(Useq + (size_t)i * ZLD), f); }
    else if (hist && i >= -15) { const float* hp = hist + (size_t)(15 + i) * 512; const f32x4 a = *(const f32x4*)hp, b = *(const f32x4*)(hp + 4); f[0] = a.x; f[1] = a.y; f[2] = a.z; f[3] = a.w; f[4] = b.x; f[5] = b.y; f[6] = b.z; f[7] = b.w; }
    else {
#pragma unroll
        for (int e = 0; e < 8; ++e) f[e] = 0.f; }
}
__device__ __forceinline__ void pool_rows(kargs_t kargs, int l, int xx  , int w0  , int lane) {
    asm volatile("" : "+v"(lane));
    const bf16* U = (const bf16*)(AF(ws) + WS_Z) + ZC_U; bf16* mix = (bf16*)(AF(ws) + WS_Z) + ZC_MIX;
    const int c = lane * 8, w = 2 << (lane >> 4);
    constexpr int NBLK_P = MP / 64;
    for (int k = w0; k < 132; k += 128) { const int blk = k < 128 ? xx * 128 + k : NBLK_P + 4 * xx + (k - 128);
        const int row0 = blk * 64; const bool samp = blk >= NBLK_P;
        const int t0 = samp ? 0 : (row0 & (SEQ - 1));
        const bf16* Useq = U + (size_t)(row0 - t0) * ZLD + c;
        const float* hist = samp ? AF(state_pool) + ((size_t)(l * DEC_BATCH + (blk - NBLK_P)) * 15) * 512 + c : nullptr;
        float S[8];
#pragma unroll
        for (int e = 0; e < 8; ++e) S[e] = 0.f;
        for (int j = 1; j < 16; ++j) if (j < w) { float f[8]; pool_ext(Useq, hist, t0 - j, f);
#pragma unroll
            for (int e = 0; e < 8; ++e) S[e] += f[e]; }
        bf16* mrow = mix + (size_t)row0 * ZLD + 512 + c;
#pragma unroll 4
        for (int i = 0; i < 64; ++i) {
            const int t = t0 + i; float cur[8], old[8];
            pool_ext(Useq, hist, t, cur);
#pragma unroll
            for (int e = 0; e < 8; ++e) S[e] += cur[e];
            const int cnt = samp ? w : ((t + 1) < w ? (t + 1) : w); const float ic = 1.0f / (float)cnt;
            v4u o; o.x = pk2(S[0] * ic - cur[0], S[1] * ic - cur[1]); o.y = pk2(S[2] * ic - cur[2], S[3] * ic - cur[3]); o.z = pk2(S[4] * ic - cur[4], S[5] * ic - cur[5]); o.w = pk2(S[6] * ic - cur[6], S[7] * ic - cur[7]);
            *(v4u*)(mrow + (size_t)i * ZLD) = o;
            pool_ext(Useq, hist, t - w + 1, old);
#pragma unroll
            for (int e = 0; e < 8; ++e) S[e] -= old[e];
        }
    }
}

__global__ void __launch_bounds__(NWAVES * 64, 2) fwd_kernel(Args args) {
    extern __shared__ __attribute__((aligned(16))) unsigned char lds_raw[];
    Frame F;
    F.lds = (LAS unsigned char*)lds_raw;
    volatile LAS unsigned* MISC = (volatile LAS unsigned*)(F.lds + MISC_OFF);
    F.G = gridDim.x; { const int bx = blockIdx.x; F.vcu = (F.G % 8 == 0) ? (bx % 8) * (F.G / 8) + bx / 8 : bx; }
    const kargs_t kargs0 = (kargs_t)__builtin_amdgcn_kernarg_segment_ptr();
    gu32* ctl; { const kargs_t kargs = kargs0; ctl = (gu32*)(AF(ws) + WS_CTL); }
    for (int u = threadIdx.x; u < (LDS_BYTES - LDSCTL_OFF) / 4; u += NWAVES * 64) ((LAS unsigned*)(F.lds + LDSCTL_OFF))[u] = 0u;
    __syncthreads();
    XcdBarrier bar; bar.bar = (unsigned*)(ctl + CW_BAR); bar.x = 0; bar.st = nullptr;
    if (!MK_PER_PHASE) bar = xcd_barrier_post((unsigned*)(ctl + CW_BAR), MISC + 8);
    int lo, hi; { const kargs_t kargs = kargs0; lo = AF(ph_lo); hi = AF(ph_hi); } (void)lo; (void)hi;
#if MK_PER_PHASE
#define IN(k) (lo <= (k) && (k) < hi)
#else
#define IN(k) true
#endif
#define SEAM(k) do { if (!MK_PER_PHASE && IN((k) + 1)) { unsigned zb_ = 0u; asm volatile("" : "+s"(zb_)); XcdBarrier b2_; b2_.bar = bar.bar + zb_; b2_.x = bar.x + zb_; b2_.st = bar.st;     \
        xcd_barrier(b2_); } } while (0)
#define SEAM_L(k) do { if (!MK_PER_PHASE) { unsigned zb_ = 0u; asm volatile("" : "+s"(zb_)); XcdBarrier b2_; b2_.bar = bar.bar + zb_; b2_.x = bar.x + zb_; b2_.st = bar.st; \
        if (__builtin_amdgcn_readfirstlane((int)b2_.st[3]) == 1) xcd_local_barrier(b2_); else xcd_barrier(b2_); } } while (0)
#define PHASE_BASES() unsigned z_ = 0u; asm volatile("" : "+s"(z_)); const kargs_t kargs = kargs0 + z_; unsigned char* ws = AF(ws); float* outb = AF(out); const int vcu = F.vcu + (int)z_, bid = (int)blockIdx.x + (int)z_, G = F.G + (int)z_; (void)vcu; (void)bid; (void)G; \
    int tid_p = threadIdx.x; asm volatile("" : "+v"(tid_p)); const int lane_p = tid_p & 63, wave_p = __builtin_amdgcn_readfirstlane(tid_p >> 6); (void)lane_p; (void)wave_p; \
    float* ss = (float*)(ws + WS_SS); bf16* XB = (bf16*)(ws + WS_XB); float* X = outb + O_YP; (void)ss; (void)XB; (void)X

    if (IN(0)) { unsigned z0_ = 0u; asm volatile("" : "+s"(z0_)); p0_prologue(kargs0 + z0_, F); SEAM(0); }
#if !MK_PER_PHASE
    if (__builtin_amdgcn_readfirstlane((int)bar.st[3]) == 1) F.vcu = (int)bar.x * 32 + __builtin_amdgcn_readfirstlane((int)bar.st[2]);
#endif

    for (int l = 0; l < DEPTH; ++l) {
        const int pb = 1 + 8 * l;
        if (IN(pb + 0)) {
            PHASE_BASES(); unsigned char* wl = ws + WS_W + (size_t)l * W_LAYER; (void)wl;
            { pg8::Gemm g{XB, (const bf16*)(wl + W_IN), MP, 2048, DM, DM}; pg8::XcdOrder S; S.init(2048, vcu >> 5, vcu & 31);
              pg8::EpiInProj E{ss + (size_t)(3 * l) * MT, (bf16*)(ws + WS_Z) + ZC_QA, (bf16*)(ws + WS_Z) + ZC_KA, (bf16*)(ws + WS_Z) + ZC_VA, (bf16*)(ws + WS_Z) + ZC_U,
                               outb + O_KP + (size_t)l * MP * 512, outb + O_VP + (size_t)l * MP * 512, outb + O_KS + (size_t)l * MS * 512, outb + O_VS + (size_t)l * MS * 512,
                               outb + O_PP + (size_t)l * BATCH * 15 * 512, outb + O_PS + (size_t)l * DEC_BATCH * 15 * 512, 0.18033688011112042f};
              if (vcu & 1) { pg8::small_gemm<8, 0, 0, 64>(F.lds, XB + (size_t)MP * DM, DM, (const bf16*)(wl + W_IN), DM, MP, vcu, E); }
              pg8::gemm_phase<pg8::EpiInProj, pg8::XcdOrder, true, true>(F.lds, g, S, E);
              if (!(vcu & 1)) { pg8::small_gemm<8, 0, 0, 64>(F.lds, XB + (size_t)MP * DM, DM, (const bf16*)(wl + W_IN), DM, MP, vcu, E); } }
            if (l == 0) {
              pg8::Gemm g{(const bf16*)(ws + WS_MEMB), (const bf16*)(ws + WS_W + W_KV), BATCH * NMEM, 4096, DM, DM}; pg8::OneUnit S{vcu >> 5, vcu & 31, (vcu & 31) < 16};
              pg8::EpiMemKV E{ss + 7 * MT, outb + O_MKP, outb + O_MVP, (bf16*)(ws + WS_MKP), (bf16*)(ws + WS_MVP)};
              pg8::gemm_phase<pg8::EpiMemKV, pg8::OneUnit, true, true>(F.lds, g, S, E); }
            SEAM_L(pb + 0);
        }
        if (IN(pb + 1)) {
            PHASE_BASES(); unsigned char* wl = ws + WS_W + (size_t)l * W_LAYER; (void)wl;
            const float lam_init = l == 0 ? 0.2f : 0.35550906759096926f;
            float lam;
            { const float a = AF(lam_q)[l * 128 + lane_p] * AF(lam_k)[l * 128 + lane_p], b = AF(lam_q)[l * 128 + 64 + lane_p] * AF(lam_k)[l * 128 + 64 + lane_p];
              const float lv = __expf(wave_sum(a)) - __expf(wave_sum(b)) + lam_init;
              lam = __builtin_bit_cast(float, __builtin_amdgcn_readfirstlane(__builtin_bit_cast(int, lv))); }
            const float post = l == 0 ? 0.8f : 0.6444909324090307f;     const float* subg = AF(subln_g) + l * 128;
            const bf16* Qa = (const bf16*)(ws + WS_Z) + ZC_QA; const bf16* Ka = (const bf16*)(ws + WS_Z) + ZC_KA; const bf16* Va = (const bf16*)(ws + WS_Z) + ZC_VA; bf16* mix = (bf16*)(ws + WS_Z) + ZC_MIX;
            if (G == 256) {
                for (int r4 = 0; r4 < 3; ++r4) { const int bh2 = (vcu >> 5) * 4 + r4, j = vcu & 31;
                    att::diff_prompt_unit(F.lds, Qa, Ka, Va, mix, bh2 >> 2, bh2 & 3, 63 - j, lam, post, subg);
                    att::diff_prompt_unit(F.lds, Qa, Ka, Va, mix, bh2 >> 2, bh2 & 3, j, lam, post, subg); }
                att::diff_prompt_unit(F.lds, Qa, Ka, Va, mix, vcu >> 5, 3, 63 - (vcu & 31), lam, post, subg);
                if ((vcu & 31) < 16) att::diff_sample_unit(F.lds, Qa, Ka, Va, AF(cache_k) + (size_t)l * DEC_BATCH * PAST * 512, AF(cache_v) + (size_t)l * DEC_BATCH * PAST * 512, mix, 4 * (vcu >> 5) + ((vcu & 31) >> 2), vcu & 3, lam, post, subg);
                if ((vcu & 31) >= 16) { int t2_ = threadIdx.x; asm volatile("" : "+v"(t2_)); pool_rows(kargs, l, vcu >> 5, ((vcu & 31) - 16) * NWAVES + __builtin_amdgcn_readfirstlane(t2_ >> 6), t2_ & 63); }
                { unsigned* qctr = (unsigned*)(ws + WS_CTL) + CW_TICKET + (l * 8 + (vcu >> 5)) * 64;
                  for (;;) {
                      asm volatile("s_waitcnt vmcnt(0)" ::: "memory"); __syncthreads();
                      if (threadIdx.x == 0) MISC[12] = __hip_atomic_fetch_add(qctr, 1u, __ATOMIC_RELAXED, __HIP_MEMORY_SCOPE_AGENT);
                      __syncthreads();
                      const int q = __builtin_amdgcn_readfirstlane((int)MISC[12]);
                      if (q >= 32) {
                          if (l != 0 || q >= 64) break;
                          const int c = q - 32, hf = c & 1, st = (c >> 1) & 3, kv = (c >> 3) & 1, ly = c >> 4;
                          const size_t e0 = ((size_t)(ly * DEC_BATCH + 4 * (vcu >> 5) + st) * NMEM * DM) + (size_t)hf * (NMEM * DM / 2) + (size_t)threadIdx.x * 8;
                          const float* sp = (kv ? AF(cache_mem_v) : AF(cache_mem_k)) + e0; bf16* dp = (bf16*)(ws + (kv ? WS_MVS : WS_MKS)) + e0;
#pragma unroll 4
                          for (int i = 0; i < 32; ++i) { const float* s8 = sp + (size_t)i * 4096; const f32x4 a = *(const f32x4*)s8, b2 = *(const f32x4*)(s8 + 4);
                              v4u o; o.x = pk2(a.x, a.y); o.y = pk2(a.z, a.w); o.z = pk2(b2.x, b2.y); o.w = pk2(b2.z, b2.w);
                              *(v4u*)(dp + (size_t)i * 4096) = o; }
                          continue; }
                      att::diff_prompt_unit(F.lds, Qa, Ka, Va, mix, vcu >> 5, 3, 31 - q, lam, post, subg); } }
            }
            SEAM_L(pb + 1);
        }
        if (IN(pb + 2)) {
            PHASE_BASES(); unsigned char* wl = ws + WS_W + (size_t)l * W_LAYER; (void)wl;
            pg8::Gemm g{(const bf16*)(ws + WS_Z) + ZC_MIX, (const bf16*)(wl + W_OUT), MP, DM, DM, ZLD}; pg8::XcdOrder S; S.init(DM, vcu >> 5, vcu & 31);
            pg8::EpiRes E{XB, ss + (size_t)(1 + 3 * l) * MT};
            if (vcu & 1) { pg8::small_gemm<4, 1, 0, 128>(F.lds, (const bf16*)(ws + WS_Z) + ZC_MIX + (size_t)MP * ZLD, ZLD, (const bf16*)(wl + W_OUT), DM, MP, vcu, E); }
            pg8::gemm_phase<pg8::EpiRes, pg8::XcdOrder, true, true>(F.lds, g, S, E);
            if (!(vcu & 1)) { pg8::small_gemm<4, 1, 0, 128>(F.lds, (const bf16*)(ws + WS_Z) + ZC_MIX + (size_t)MP * ZLD, ZLD, (const bf16*)(wl + W_OUT), DM, MP, vcu, E); }
            SEAM_L(pb + 2);
        }
        if (IN(pb + 3)) {
            PHASE_BASES(); unsigned char* wl = ws + WS_W + (size_t)l * W_LAYER; (void)wl;
            pg8::Gemm g{XB, (const bf16*)(wl + W_Q), MP, DM, DM, DM}; pg8::XcdOrder S; S.init(DM, vcu >> 5, vcu & 31);
            pg8::EpiRowScale<0> E{ss + (size_t)(1 + 3 * l) * MT, (bf16*)(ws + WS_Z) + ZC_QX, ZLD, 0.09016844005556021f};
            if (vcu & 1) { pg8::small_gemm<4, 2, 0, 128>(F.lds, XB + (size_t)MP * DM, DM, (const bf16*)(wl + W_Q), DM, MP, vcu, E); }
            pg8::gemm_phase<pg8::EpiRowScale<0>, pg8::XcdOrder, true, true>(F.lds, g, S, E);
            if (!(vcu & 1)) { pg8::small_gemm<4, 2, 0, 128>(F.lds, XB + (size_t)MP * DM, DM, (const bf16*)(wl + W_Q), DM, MP, vcu, E); }
            SEAM_L(pb + 3);
        }
        if (IN(pb + 4)) {
            PHASE_BASES(); unsigned char* wl = ws + WS_W + (size_t)l * W_LAYER; (void)wl;
            const bf16* QX = (const bf16*)(ws + WS_Z) + ZC_QX; bf16* OX = (bf16*)(ws + WS_Z) + ZC_OX;
            const bf16* MKP_ = (const bf16*)(ws + WS_MKP) + (size_t)l * 2048 * DM; const bf16* MVP_ = (const bf16*)(ws + WS_MVP) + (size_t)l * 2048 * DM;
            const bf16* MKS_ = (const bf16*)(ws + WS_MKS) + (size_t)l * DEC_BATCH * NMEM * DM; const bf16* MVS_ = (const bf16*)(ws + WS_MVS) + (size_t)l * DEC_BATCH * NMEM * DM;
            for (int u = vcu * 4; u < 1024; u += G * 4)
                for (int i = 0; i < 4; ++i) { const int tile = (u + i) >> 2, h = (u + i) & 3, b = tile >> 5;
                    att::cross_unit<8>(F.lds, QX + (size_t)tile * 256 * ZLD, MKP_ + (size_t)b * NMEM * DM, MVP_ + (size_t)b * NMEM * DM, OX + (size_t)tile * 256 * ZLD, h); }
            if ((vcu & 31) < 16) { const int b = 4 * (vcu >> 5) + ((vcu & 31) >> 2), h = vcu & 3;
                att::cross_unit<2>(F.lds, QX + (size_t)(MP + b * 64) * ZLD, MKS_ + (size_t)b * NMEM * DM, MVS_ + (size_t)b * NMEM * DM, OX + (size_t)(MP + b * 64) * ZLD, h); }
            SEAM_L(pb + 4);
        }
        if (IN(pb + 5)) {
            PHASE_BASES(); unsigned char* wl = ws + WS_W + (size_t)l * W_LAYER; (void)wl;
            pg8::Gemm g{(const bf16*)(ws + WS_Z) + ZC_OX, (const bf16*)(wl + W_O), MP, DM, DM, ZLD}; pg8::XcdOrder S; S.init(DM, vcu >> 5, vcu & 31);
            pg8::EpiRes E{XB, ss + (size_t)(2 + 3 * l) * MT};
            if (vcu & 1) { pg8::small_gemm<4, 1, 0, 128>(F.lds, (const bf16*)(ws + WS_Z) + ZC_OX + (size_t)MP * ZLD, ZLD, (const bf16*)(wl + W_O), DM, MP, vcu, E); }
            pg8::gemm_phase<pg8::EpiRes, pg8::XcdOrder, true, true>(F.lds, g, S, E);
            if (!(vcu & 1)) { pg8::small_gemm<4, 1, 0, 128>(F.lds, (const bf16*)(ws + WS_Z) + ZC_OX + (size_t)MP * ZLD, ZLD, (const bf16*)(wl + W_O), DM, MP, vcu, E); }
            SEAM_L(pb + 5);
        }
        if (IN(pb + 6)) {
            PHASE_BASES(); unsigned char* wl = ws + WS_W + (size_t)l * W_LAYER; (void)wl;
            pg8::Gemm g{XB, (const bf16*)(wl + W_UP), MP, DFF, DM, DM}; pg8::XcdOrder S; S.init(DFF, vcu >> 5, vcu & 31);
            pg8::EpiRowScale<1> E{ss + (size_t)(2 + 3 * l) * MT, (bf16*)(ws + WS_Z), DFF, 1.0f};
            if (vcu & 1) { pg8::small_gemm<16, 2, 1, 64>(F.lds, XB + (size_t)MP * DM, DM, (const bf16*)(wl + W_UP), DM, MP, vcu, E); }
            pg8::gemm_phase<pg8::EpiRowScale<1>, pg8::XcdOrder, true, true>(F.lds, g, S, E);
            if (!(vcu & 1)) { pg8::small_gemm<16, 2, 1, 64>(F.lds, XB + (size_t)MP * DM, DM, (const bf16*)(wl + W_UP), DM, MP, vcu, E); }
            SEAM_L(pb + 6);
        }
        if (IN(pb + 7)) {
            PHASE_BASES(); unsigned char* wl = ws + WS_W + (size_t)l * W_LAYER; (void)wl;
            pg8::Gemm g{(const bf16*)(ws + WS_Z), (const bf16*)(wl + W_DOWN), MP, DM, DFF, DFF}; pg8::XcdOrder S; S.init(DM, vcu >> 5, vcu & 31);
            pg8::EpiRes E{XB, ss + (size_t)(3 + 3 * l) * MT};
            if (vcu & 1) { pg8::small_gemm<4, 1, 0, 128>(F.lds, (const bf16*)(ws + WS_Z) + (size_t)MP * DFF, DFF, (const bf16*)(wl + W_DOWN), DFF, MP, vcu, E); }
            pg8::gemm_phase<pg8::EpiRes, pg8::XcdOrder, true, true>(F.lds, g, S, E);
            if (!(vcu & 1)) { pg8::small_gemm<4, 1, 0, 128>(F.lds, (const bf16*)(ws + WS_Z) + (size_t)MP * DFF, DFF, (const bf16*)(wl + W_DOWN), DFF, MP, vcu, E); }
            SEAM_L(pb + 7);
        }
    }
    if (IN(17)) {
        PHASE_BASES();
        const int ln = lane_p;
        const float* sq = ss + (size_t)6 * MT; const GAS f32x4* gp = (const GAS f32x4*)AF(final_g) + ln;
        const f32x4 g0 = gp[0], g1 = gp[64], g2 = gp[128], g3 = gp[192];
        for (int k = (vcu & 31) * NWAVES + wave_p; k < 8448; k += 32 * NWAVES) { const int m = k < 8192 ? (vcu >> 5) * 8192 + k : MP + (vcu >> 5) * 256 + (k - 8192);
            const float rs = 1.0f / sqrtf(sq[m] * (1.0f / 1024.0f) + 1e-6f);
            const GAS unsigned long long* xr = (const GAS unsigned long long*)(XB + (size_t)m * DM) + ln;
            GAS f32x4* yr = (GAS f32x4*)(X + (size_t)m * DM) + ln;
            const unsigned long long q0 = xr[0], q1 = xr[64], q2 = xr[128], q3 = xr[192];
#define UNP4(q) (f32x4){__builtin_bit_cast(float, (unsigned)(q) << 16), __builtin_bit_cast(float, (unsigned)(q) & 0xffff0000u), __builtin_bit_cast(float, (unsigned)((q) >> 32) << 16), __builtin_bit_cast(float, (unsigned)((q) >> 32) & 0xffff0000u)}
            yr[0] = UNP4(q0) * rs * g0; yr[64] = UNP4(q1) * rs * g1; yr[128] = UNP4(q2) * rs * g2; yr[192] = UNP4(q3) * rs * g3;
#undef UNP4
        }
    }
#undef IN
#undef SEAM
}

extern "C" void kernel_launch(void* const* d_in, const int* in_sizes, int n_in, void* d_out, int out_size, void* d_ws, size_t ws_size, hipStream_t stream) {
    static int grid = 0;
    if (grid == 0) {
        if (n_in != 26 || in_sizes[0] != MP * DM || (size_t)out_size != O_END || ws_size < WS_END) {
            fprintf(stderr, "kernel_launch: shape mismatch: n_in %d in0 %d out %d (want %zu) ws %zu (need %zu); nothing launched\n", n_in, n_in > 0 ? in_sizes[0] : -1, out_size, (size_t)O_END, ws_size, (size_t)WS_END); grid = -1; return; }
        int dev = 0, cus = 0, per_cu = 0;
        if (hipGetDevice(&dev) != hipSuccess || hipDeviceGetAttribute(&cus, hipDeviceAttributeMultiprocessorCount, dev) != hipSuccess) { fprintf(stderr, "kernel_launch: device query failed\n"); grid = -1; return; }
        if (hipFuncSetAttribute((const void*)fwd_kernel, hipFuncAttributeMaxDynamicSharedMemorySize, LDS_BYTES) != hipSuccess) { fprintf(stderr, "kernel_launch: hipFuncSetAttribute failed\n"); grid = -1; return; }
        if (hipOccupancyMaxActiveBlocksPerMultiprocessor(&per_cu, (const void*)fwd_kernel, NWAVES * 64, LDS_BYTES) != hipSuccess || per_cu < 1)
            fprintf(stderr, "kernel_launch: note: occupancy query reports %d workgroups per CU\n", per_cu);
        (void)hipGetLastError();
        if (cus != 256) { fprintf(stderr, "kernel_launch: built for a 256-CU device (the attention phase deals its units over exactly 256 workgroups), found %d CUs; nothing launched\n", cus); grid = -1; return; }
        grid = cus;
    }
    if (grid < 0) return;
    if (hipMemsetAsync((char*)d_ws + WS_CTL, 0, CTL_ZERO_BYTES, stream) != hipSuccess) { fprintf(stderr, "kernel_launch: memset failed\n"); return; }
    Args a{};
    const float** ap = (const float**)&a;
    for (int i = 0; i < 26; ++i) ap[i] = (const float*)d_in[i];
    a.out = (float*)d_out; a.ws = (unsigned char*)d_ws;
#if MK_PER_PHASE
    for (int p = 0; p < NPH; ++p) { a.ph_lo = p; a.ph_hi = p + 1; hipLaunchKernelGGL(fwd_kernel, dim3(grid), dim3(NWAVES * 64), LDS_BYTES, stream, a); }
#else
    a.ph_lo = 0; a.ph_hi = NPH; hipLaunchKernelGGL(fwd_kernel, dim3(grid), dim3(NWAVES * 64), LDS_BYTES, stream, a);
#endif
    const hipError_t le = hipPeekAtLastError();
    if (le != hipSuccess) fprintf(stderr, "kernel_launch: launch failed: %s\n", hipGetErrorName(le));
}
```
